# Optimizing an MI355X kernel written in HIP

```python
import math
import jax, jax.numpy as jnp
from jax import lax
import numpy as np

D_MODEL = 1024
BATCH = 8
SEQ = 4096
DEPTH = 2

RG_WIDTH = 512
RG_HEADS = 8
RG_HEAD_DIM = RG_WIDTH // RG_HEADS
RG_CONV = 4
RG_C = 8.0
SB_HEADS = 8
SB_HEAD_DIM = 64
SB_WIDTH = SB_HEADS * SB_HEAD_DIM
SB_QBLOCK = 128
AB_IN = 2 * RG_WIDTH + 3 * SB_WIDTH
AB_MIX = RG_WIDTH + SB_WIDTH

S5_WIDTH = 512
S5_GROUP = 16
S5_GROUPS = S5_WIDTH // S5_GROUP
S5_STATE = 64
MOBA_HEADS = 4
MOBA_HEAD_DIM = 128
MOBA_WIDTH = MOBA_HEADS * MOBA_HEAD_DIM
MOBA_BLOCK = 256
MOBA_TOPK = 3
MOBA_QCHUNK = 32
CD_IN = S5_WIDTH + 3 * MOBA_WIDTH
CD_MIX = S5_WIDTH + MOBA_WIDTH

FFN_HIDDEN = ((8 * D_MODEL + 3 * 256 - 1) // (3 * 256)) * 256
N_EVEN = (DEPTH + 1) // 2
N_ODD = DEPTH // 2
EPS = 1e-6

kernel_name = "hybrid_rglru_stickbreak_s5_moba"


def rms_norm(x, g):
    xf = x.astype(jnp.float32)
    y = xf * lax.rsqrt(jnp.mean(xf * xf, axis=-1, keepdims=True) + EPS)
    return (y * g.astype(jnp.float32)).astype(x.dtype)


def swiglu(h, w_gate, w_up, w_down):
    return (jax.nn.silu(h @ w_gate) * (h @ w_up)) @ w_down


def alibi_slopes(n_heads):
    return 2.0 ** (-8.0 * jnp.arange(1, n_heads + 1, dtype=jnp.float32) / n_heads)


def rglru_branch(xr, gate, conv_w, conv_b, wa, ba, wx, bx, lam):
    f32 = jnp.float32
    B_, S_, _ = xr.shape
    xc = lax.conv_general_dilated(xr, conv_w, window_strides=(1,), padding=[(RG_CONV - 1, 0)],
                                  dimension_numbers=('NWC', 'WIO', 'NWC'),
                                  feature_group_count=RG_WIDTH) + conv_b
    xh = xc.reshape(B_, S_, RG_HEADS, RG_HEAD_DIM)
    r = jax.nn.sigmoid(jnp.einsum('bshi,hij->bshj', xh, wa) + ba).reshape(B_, S_, RG_WIDTH)
    i = jax.nn.sigmoid(jnp.einsum('bshi,hij->bshj', xh, wx) + bx).reshape(B_, S_, RG_WIDTH)
    log_a = (-RG_C * r.astype(f32)) * jax.nn.softplus(-lam.astype(f32))
    a = jnp.exp(log_a)
    b = jnp.sqrt(-jnp.expm1(2.0 * log_a)) * (i * xc).astype(f32)

    def combine(l, rr):
        a_l, b_l = l
        a_r, b_r = rr
        return a_r * a_l, a_r * b_l + b_r

    _, h = lax.associative_scan(combine, (a, b), axis=1)
    return h.astype(xr.dtype) * jax.nn.gelu(gate)


def stick_breaking_attention(q, k, v):
    f32 = jnp.float32
    S_ = q.shape[2]
    scale = SB_HEAD_DIM ** -0.5
    outs = []
    for blk in range(S_ // SB_QBLOCK):
        q0 = blk * SB_QBLOCK
        kend = q0 + SB_QBLOCK
        z = jnp.einsum('bhqd,bhkd->bhqk', q[:, :, q0:kend], k[:, :, :kend]).astype(f32) * scale
        q_pos = q0 + jnp.arange(SB_QBLOCK)
        k_pos = jnp.arange(kend)
        past = k_pos[None, :] < q_pos[:, None]
        log_keep = jnp.where(past, jax.nn.log_sigmoid(-z), 0.0)
        later = lax.cumsum(log_keep, axis=3, reverse=True) - log_keep
        w = jnp.where(past, jnp.exp(jax.nn.log_sigmoid(z) + later), 0.0)
        outs.append(jnp.einsum('bhqk,bhkd->bhqd', w.astype(v.dtype), v[:, :, :kend]))
    return jnp.concatenate(outs, axis=2)


def s5_branch(u, lam_re, lam_im, log_dt, b_re, b_im, c_re, c_im, d_skip, glu_w, glu_b):
    f32 = jnp.float32
    B_, S_, _ = u.shape
    uf = u.astype(f32).reshape(B_, S_, S5_GROUPS, S5_GROUP)
    dt = jnp.exp(log_dt.astype(f32))[:, None]
    lr, li = lam_re.astype(f32), lam_im.astype(f32)
    mag = jnp.exp(lr * dt)
    ab_re, ab_im = mag * jnp.cos(li * dt), mag * jnp.sin(li * dt)
    den = lr * lr + li * li
    nr, ni = ab_re - 1.0, ab_im
    f_re = (nr * lr + ni * li) / den
    f_im = (ni * lr - nr * li) / den
    br, bi = b_re.astype(f32), b_im.astype(f32)
    bb_re = f_re[..., None] * br - f_im[..., None] * bi
    bb_im = f_re[..., None] * bi + f_im[..., None] * br
    bu_re = jnp.einsum('bsgp,gnp->bsgn', uf, bb_re)
    bu_im = jnp.einsum('bsgp,gnp->bsgn', uf, bb_im)
    a_re = jnp.broadcast_to(ab_re, (1, S_) + ab_re.shape)
    a_im = jnp.broadcast_to(ab_im, (1, S_) + ab_im.shape)

    def combine(l, r):
        ar_l, ai_l, br_l, bi_l = l
        ar_r, ai_r, br_r, bi_r = r
        return (ar_r * ar_l - ai_r * ai_l,
                ar_r * ai_l + ai_r * ar_l,
                ar_r * br_l - ai_r * bi_l + br_r,
                ar_r * bi_l + ai_r * br_l + bi_r)

    _, _, x_re, x_im = lax.associative_scan(combine, (a_re, a_im, bu_re, bu_im), axis=1)
    y = (jnp.einsum('bsgn,gpn->bsgp', x_re, c_re.astype(f32))
         - jnp.einsum('bsgn,gpn->bsgp', x_im, c_im.astype(f32)))
    y = y.reshape(B_, S_, S5_WIDTH) + d_skip.astype(f32) * u.astype(f32)
    y = jax.nn.gelu(y)
    y = y * jax.nn.sigmoid(y @ glu_w.astype(f32) + glu_b.astype(f32))
    return y.astype(u.dtype)


def moba_attention(q, k, v):
    f32 = jnp.float32
    B_, H_, S_, hd = q.shape
    n_blk = -(-S_ // MOBA_BLOCK)
    s_pad = n_blk * MOBA_BLOCK
    pad = [(0, 0), (0, 0), (0, s_pad - S_), (0, 0)]
    q, k, v = jnp.pad(q, pad), jnp.pad(k, pad), jnp.pad(v, pad)
    k_blocks = k.reshape(B_, H_, n_blk, MOBA_BLOCK, hd)
    v_blocks = v.reshape(B_, H_, n_blk, MOBA_BLOCK, hd)
    k_mean = jnp.mean(k_blocks.astype(f32), axis=3)
    gate = jnp.einsum('bhsd,bhnd->bhsn', q.astype(f32), k_mean)
    q_blk = jnp.arange(s_pad) // MOBA_BLOCK
    fully_past = jnp.arange(n_blk)[None, :] < q_blk[:, None]
    gate = jnp.where(fully_past, gate, -jnp.inf)
    n_sel = min(MOBA_TOPK, n_blk)
    _, sel = lax.top_k(gate, n_sel)

    n_chunk = s_pad // MOBA_QCHUNK
    q_c = q.reshape(B_, H_, n_chunk, MOBA_QCHUNK, hd).transpose(2, 0, 1, 3, 4)
    sel_c = sel.reshape(B_, H_, n_chunk, MOBA_QCHUNK, n_sel).transpose(2, 0, 1, 3, 4)
    gather = jax.vmap(jax.vmap(lambda blocks, idx: blocks[idx]))
    slopes = alibi_slopes(H_)[None, :, None, None]
    scale = hd ** -0.5
    in_blk = jnp.arange(MOBA_BLOCK)
    n_s = n_sel * MOBA_BLOCK

    def chunk(args):
        c, qc, sc = args
        t = c * MOBA_QCHUNK + jnp.arange(MOBA_QCHUNK)
        own = (c * MOBA_QCHUNK) // MOBA_BLOCK
        k_sel = gather(k_blocks, sc).reshape(B_, H_, MOBA_QCHUNK, n_s, hd)
        v_sel = gather(v_blocks, sc).reshape(B_, H_, MOBA_QCHUNK, n_s, hd)
        k_own = lax.dynamic_slice_in_dim(k, own * MOBA_BLOCK, MOBA_BLOCK, axis=2)
        v_own = lax.dynamic_slice_in_dim(v, own * MOBA_BLOCK, MOBA_BLOCK, axis=2)
        s_pos_sel = (sc[..., None] * MOBA_BLOCK + in_blk).reshape(B_, H_, MOBA_QCHUNK, n_s)
        ok_sel = jnp.repeat(jnp.arange(n_sel) < own, MOBA_BLOCK)
        s_pos_own = own * MOBA_BLOCK + in_blk
        ok_own = s_pos_own[None, :] <= t[:, None]
        sc_sel = (jnp.einsum('bhqd,bhqkd->bhqk', qc, k_sel).astype(f32) * scale
                  - slopes * (t[:, None] - s_pos_sel).astype(f32))
        sc_sel = jnp.where(ok_sel, sc_sel, -jnp.inf)
        sc_own = (jnp.einsum('bhqd,bhkd->bhqk', qc, k_own).astype(f32) * scale
                  - slopes * (t[:, None] - s_pos_own[None, :]).astype(f32))
        sc_own = jnp.where(ok_own, sc_own, -jnp.inf)
        p = jax.nn.softmax(jnp.concatenate([sc_sel, sc_own], axis=-1), axis=-1).astype(v.dtype)
        return (jnp.einsum('bhqk,bhqkd->bhqd', p[..., :n_s], v_sel)
                + jnp.einsum('bhqk,bhkd->bhqd', p[..., n_s:], v_own))

    out = lax.map(chunk, (jnp.arange(n_chunk), q_c, sel_c))
    return out.transpose(1, 2, 0, 3, 4).reshape(B_, H_, s_pad, hd)[:, :, :S_]


def ab_mixer(h, w_in, conv_w, conv_b, wa, ba, wx, bx, lam, w_out):
    B_, S_, _ = h.shape
    proj = h @ w_in
    xr, gate, q, k, v = jnp.split(
        proj, [RG_WIDTH, 2 * RG_WIDTH, 2 * RG_WIDTH + SB_WIDTH, 2 * RG_WIDTH + 2 * SB_WIDTH], axis=-1)
    y_rg = rglru_branch(xr, gate, conv_w, conv_b, wa, ba, wx, bx, lam)
    heads = lambda t: t.reshape(B_, S_, SB_HEADS, SB_HEAD_DIM).transpose(0, 2, 1, 3)
    y_sb = stick_breaking_attention(heads(q), heads(k), heads(v))
    y_sb = y_sb.transpose(0, 2, 1, 3).reshape(B_, S_, SB_WIDTH).astype(y_rg.dtype)
    return jnp.concatenate([y_rg, y_sb], axis=-1) @ w_out


def cd_mixer(h, w_in, lam_re, lam_im, log_dt, b_re, b_im, c_re, c_im, d_skip, glu_w, glu_b, w_out):
    B_, S_, _ = h.shape
    proj = h @ w_in
    u, q, k, v = jnp.split(proj, [S5_WIDTH, S5_WIDTH + MOBA_WIDTH, S5_WIDTH + 2 * MOBA_WIDTH], axis=-1)
    y_s5 = s5_branch(u, lam_re, lam_im, log_dt, b_re, b_im, c_re, c_im, d_skip, glu_w, glu_b)
    heads = lambda t: t.reshape(B_, S_, MOBA_HEADS, MOBA_HEAD_DIM).transpose(0, 2, 1, 3)
    y_mb = moba_attention(heads(q), heads(k), heads(v))
    y_mb = y_mb.transpose(0, 2, 1, 3).reshape(B_, S_, MOBA_WIDTH).astype(y_s5.dtype)
    return jnp.concatenate([y_s5, y_mb], axis=-1) @ w_out


def setup_inputs(seed: int = 0) -> dict:
    key = jax.random.key(seed)
    ks = iter(jax.random.split(key, 32))
    f32 = jnp.float32
    NE, NO = N_EVEN, N_ODD
    G, N, P = S5_GROUPS, S5_STATE, S5_GROUP

    def nrm(shape, scale):
        return jax.random.normal(next(ks), shape, f32) * scale

    def gain(shape):
        return 1.0 + 0.01 * jax.random.normal(next(ks), shape, f32)

    x = jax.random.normal(next(ks), (BATCH, SEQ, D_MODEL), f32)
    ab_norm = gain((NE, D_MODEL))
    ab_w_in = nrm((NE, D_MODEL, AB_IN), D_MODEL ** -0.5)
    ab_conv_w = nrm((NE, RG_CONV, 1, RG_WIDTH), RG_CONV ** -0.5)
    ab_conv_b = nrm((NE, RG_WIDTH), 0.01)
    ab_gate_a_w = nrm((NE, RG_HEADS, RG_HEAD_DIM, RG_HEAD_DIM), RG_HEAD_DIM ** -0.5)
    ab_gate_a_b = nrm((NE, RG_HEADS, RG_HEAD_DIM), 0.01)
    ab_gate_x_w = nrm((NE, RG_HEADS, RG_HEAD_DIM, RG_HEAD_DIM), RG_HEAD_DIM ** -0.5)
    ab_gate_x_b = nrm((NE, RG_HEADS, RG_HEAD_DIM), 0.01)
    a_c = jax.random.uniform(next(ks), (NE, RG_WIDTH), f32, 0.9, 0.999)
    a0 = a_c ** (1.0 / RG_C)
    ab_lambda = jnp.log(a0) - jnp.log1p(-a0)
    ab_w_out = nrm((NE, AB_MIX, D_MODEL), AB_MIX ** -0.5)

    cd_norm = gain((NO, D_MODEL))
    cd_w_in = nrm((NO, D_MODEL, CD_IN), D_MODEL ** -0.5)
    cd_lam_re = -0.5 + nrm((NO, G, N), 0.01)
    cd_lam_im = math.pi * jnp.arange(N, dtype=f32) + nrm((NO, G, N), 0.01)
    cd_log_dt = jax.random.uniform(next(ks), (NO, G), f32, math.log(1e-3), math.log(1e-1))
    cd_b_re = nrm((NO, G, N, P), (2.0 * P) ** -0.5)
    cd_b_im = nrm((NO, G, N, P), (2.0 * P) ** -0.5)
    cd_c_re = nrm((NO, G, P, N), N ** -0.5)
    cd_c_im = nrm((NO, G, P, N), N ** -0.5)
    cd_d = nrm((NO, S5_WIDTH), 1.0)
    cd_glu_w = nrm((NO, S5_WIDTH, S5_WIDTH), S5_WIDTH ** -0.5)
    cd_glu_b = nrm((NO, S5_WIDTH), 0.01)
    cd_w_out = nrm((NO, CD_MIX, D_MODEL), CD_MIX ** -0.5)

    ffn_norm = gain((DEPTH, D_MODEL))
    ffn_w_gate = nrm((DEPTH, D_MODEL, FFN_HIDDEN), D_MODEL ** -0.5)
    ffn_w_up = nrm((DEPTH, D_MODEL, FFN_HIDDEN), D_MODEL ** -0.5)
    ffn_w_down = nrm((DEPTH, FFN_HIDDEN, D_MODEL), FFN_HIDDEN ** -0.5)
    final_norm = gain((D_MODEL,))
    return {"x": x, "ab_norm": ab_norm, "ab_w_in": ab_w_in, "ab_conv_w": ab_conv_w,
            "ab_conv_b": ab_conv_b, "ab_gate_a_w": ab_gate_a_w, "ab_gate_a_b": ab_gate_a_b,
            "ab_gate_x_w": ab_gate_x_w, "ab_gate_x_b": ab_gate_x_b, "ab_lambda": ab_lambda,
            "ab_w_out": ab_w_out, "cd_norm": cd_norm, "cd_w_in": cd_w_in,
            "cd_lam_re": cd_lam_re, "cd_lam_im": cd_lam_im, "cd_log_dt": cd_log_dt,
            "cd_b_re": cd_b_re, "cd_b_im": cd_b_im, "cd_c_re": cd_c_re, "cd_c_im": cd_c_im,
            "cd_d": cd_d, "cd_glu_w": cd_glu_w, "cd_glu_b": cd_glu_b, "cd_w_out": cd_w_out,
            "ffn_norm": ffn_norm, "ffn_w_gate": ffn_w_gate, "ffn_w_up": ffn_w_up,
            "ffn_w_down": ffn_w_down, "final_norm": final_norm}


def reference(x, ab_norm, ab_w_in, ab_conv_w, ab_conv_b, ab_gate_a_w, ab_gate_a_b,
              ab_gate_x_w, ab_gate_x_b, ab_lambda, ab_w_out, cd_norm, cd_w_in,
              cd_lam_re, cd_lam_im, cd_log_dt, cd_b_re, cd_b_im, cd_c_re, cd_c_im,
              cd_d, cd_glu_w, cd_glu_b, cd_w_out, ffn_norm, ffn_w_gate, ffn_w_up,
              ffn_w_down, final_norm):
    for layer in range(DEPTH):
        j = layer // 2
        if layer % 2 == 0:
            h = rms_norm(x, ab_norm[j])
            x = x + ab_mixer(h, ab_w_in[j], ab_conv_w[j], ab_conv_b[j], ab_gate_a_w[j],
                             ab_gate_a_b[j], ab_gate_x_w[j], ab_gate_x_b[j], ab_lambda[j],
                             ab_w_out[j])
        else:
            h = rms_norm(x, cd_norm[j])
            x = x + cd_mixer(h, cd_w_in[j], cd_lam_re[j], cd_lam_im[j], cd_log_dt[j],
                             cd_b_re[j], cd_b_im[j], cd_c_re[j], cd_c_im[j], cd_d[j],
                             cd_glu_w[j], cd_glu_b[j], cd_w_out[j])
        h = rms_norm(x, ffn_norm[layer])
        x = x + swiglu(h, ffn_w_gate[layer], ffn_w_up[layer], ffn_w_down[layer])
    return rms_norm(x, final_norm)
```

```cpp
#include <hip/hip_runtime.h>
#include <cstdint>
#include <cstdio>

constexpr int D_MODEL = 1024, BATCH = 8, SEQ = 4096, MTOK = BATCH * SEQ;
constexpr int FFN = 2816;
constexpr float EPS = 1e-6f;

typedef unsigned short bf16_t;
#define LAS __attribute__((address_space(3)))
typedef short bf16x8 __attribute__((ext_vector_type(8)));
typedef float f32x4 __attribute__((ext_vector_type(4)));
typedef unsigned u32x4 __attribute__((ext_vector_type(4)));

__device__ __forceinline__ float bf2f(bf16_t v) { return __uint_as_float(((unsigned)v) << 16); }
__device__ __forceinline__ unsigned f2bf(float f) { unsigned u = __float_as_uint(f); return (u + 0x7fffu + ((u >> 16) & 1u)) >> 16; }
__device__ __forceinline__ unsigned pk2(float lo, float hi) { return f2bf(lo) | (f2bf(hi) << 16); }
__device__ __forceinline__ unsigned cvt_pk_bf16(float lo, float hi) { unsigned r; asm volatile("v_cvt_pk_bf16_f32 %0, %1, %2" : "=v"(r) : "v"(lo), "v"(hi)); return r; }
template <typename T> __device__ __forceinline__ float ldv(const T* p);
template <> __device__ __forceinline__ float ldv<float>(const float* p) { return *p; }
template <> __device__ __forceinline__ float ldv<bf16_t>(const bf16_t* p) { return bf2f(*p); }
template <typename T> __device__ __forceinline__ void stv(T* p, float v);
template <> __device__ __forceinline__ void stv<float>(float* p, float v) { *p = v; }
template <> __device__ __forceinline__ void stv<bf16_t>(bf16_t* p, float v) { *p = (bf16_t)f2bf(v); }

__device__ __forceinline__ float wave_sum(float v) {
#pragma unroll
    for (int o = 1; o < 64; o <<= 1) v += __shfl_xor(v, o);
    return v;
}
__device__ __forceinline__ float fast_sigmoid(float x) { return __builtin_amdgcn_rcpf(1.f + __builtin_amdgcn_exp2f(-1.4426950408889634f * x)); }
__device__ __forceinline__ float gelu_tanh_fast(float x) { const float u = 0.7978845608028654f * (x + 0.044715f * x * x * x); return x * fast_sigmoid(2.f * u); }
__device__ __forceinline__ float gelu_tanh(float x) { const float u = 0.7978845608028654f * (x + 0.044715f * x * x * x); return 0.5f * x * (1.f + tanhf(u)); }
__device__ __forceinline__ float sigmoidf_(float x) { return 1.f / (1.f + expf(-x)); }
__device__ __forceinline__ float logsig(float x) { return fminf(x, 0.f) - log1pf(expf(-fabsf(x))); }

constexpr size_t MiB = 1u << 20;
constexpr size_t WS_CTL = 0, CTL_ZERO_BYTES = 2 * MiB;
constexpr size_t WS_SSQ = 64 * 1024;
constexpr size_t WS_KM = 768 * 1024;
constexpr size_t WS_KN2 = 1024 * 1024;
constexpr size_t WS_A32 = 1024 * 1024 + 512 * 1024;
constexpr size_t WS_WIN0 = 2 * MiB, WS_WOUT0 = 7 * MiB, WS_WGU0 = 9 * MiB, WS_WD0 = 20 * MiB, WS_WIN1 = 26 * MiB, WS_WOUT1 = 30 * MiB;
constexpr size_t WS_WGU1 = 32 * MiB, WS_WD1 = 43 * MiB, WS_GLU = 49 * MiB, WS_E = 50 * MiB, WS_TC = 58 * MiB;
constexpr size_t WS_XB = 80 * MiB;
constexpr size_t WS_MIX = 144 * MiB;
constexpr size_t WS_YG = 208 * MiB;
constexpr size_t WS_PROJ = 240 * MiB;
constexpr size_t WS_US5 = 336 * MiB;
constexpr size_t WS_XE = 376 * MiB;
constexpr size_t WS_H = 240 * MiB;
constexpr size_t WS_END = 416 * MiB;
constexpr int US5_LD = 32 * 640;

namespace pg8 {
constexpr int BM = 256, BK = 64, HALF = 128, HTB = HALF * BK * 2, STAGE_BYTES = 8 * HTB, NXCD = 8, WGM = 8;
__host__ __device__ __forceinline__ int lds_byte(int r, int c) { const int st = (r >> 4) * 2 + (c >> 5), rr = r & 15, cc = c & 31, ob = rr * 64 + cc * 2; return st * 1024 + (ob ^ (((ob >> 9) & 1) << 5)); }
__host__ __device__ __forceinline__ void stage_rc(int b, int& R, int& C) { const int st = b / 1024, sb = b % 1024, swz = sb ^ (((sb >> 9) & 1) << 5); R = (st >> 1) * 16 + swz / 64; C = (st & 1) * 32 + (swz % 64) / 2; }
__host__ __device__ __forceinline__ int perm32(int rho) { const int n = rho >> 4, i = rho & 15; return 8 * (i >> 2) + 4 * n + (i & 3); }

struct Unit { int pm, pn, g; };
struct Gemm { const bf16_t* A; const bf16_t* Bt; int lda, ldb, K; long a_g, b_g; };

struct StaticOrder {
    int nM, nN, nwg, G, c;
    __device__ void init(int M, int N, int G_, int c_) { nM = M / BM; nN = N / BM; nwg = nM * nN; G = G_; c = c_; }
    __device__ bool next(int i, Unit& u) const {
        const long L = (long)i * G + c; if (L >= nwg) return false;
        int wgid = (int)L; { const int q = nwg / NXCD, r = nwg % NXCD, xcd = wgid % NXCD, off = wgid / NXCD; wgid = (xcd < r ? xcd * (q + 1) : r * (q + 1) + (xcd - r) * q) + off; }
        const int nig = WGM * nN, gid = wgid / nig, fm = gid * WGM, gsz = (nM - fm) < WGM ? (nM - fm) : WGM;
        u.pm = fm + ((wgid % nig) % gsz); u.pn = (wgid % nig) / gsz; u.g = 0; return true;
    }
};
struct GroupOrder {
    int nM, nN, ng, G, c;
    __device__ void init(int nM_, int nN_, int ng_, int G_, int c_) { nM = nM_; nN = nN_; ng = ng_; G = G_; c = c_; }
    __device__ bool next(int i, Unit& u) const {
        const int L = i * G + c; if (L >= nM * nN * ng) return false;
        u.g = L / (nM * nN); const int r = L % (nM * nN); u.pn = r / nM; u.pm = r % nM; return true;
    }
};

template <int MODE = 0, class Epi, class Sched, bool ALIGN_EPI = true, bool SP2 = true>
__device__ __forceinline__ void gemm_phase(LAS unsigned char* lds, const Gemm g, const Sched& S, const Epi& E) {
    const int tid = threadIdx.x, wid = __builtin_amdgcn_readfirstlane(tid >> 6), lane = tid & 63, wr = wid >> 2, wc = wid & 3, fr = lane & 15, fq = lane >> 4;
    const int K = g.K, nt = K / BK;
    unsigned voffA[2], voffB[2];
#pragma unroll
    for (int i = 0; i < 2; ++i) { int R, C; stage_rc(tid * 16 + i * 8192, R, C); const int Rb = Epi::PERM ? ((R & ~31) + perm32(R & 31)) : R;
        voffA[i] = (unsigned)(R * g.lda + C) * 2u; voffB[i] = (unsigned)(Rb * g.ldb + C) * 2u; }
    const size_t kstep = (size_t)(BK * 2);
    const size_t hstepA = (size_t)HALF * g.lda * 2, hstepB = (size_t)HALF * g.ldb * 2;
    const unsigned ldsw = (unsigned)wid * 1024u;
    const int aoff = lds_byte(wr * 64 + fr, fq * 8), boff = lds_byte(wc * 32 + fr, fq * 8);
#define PG8_SA(b, h) (((b) * 2 + (h)) * HTB)
#define PG8_SB(b, h) ((4 + (b) * 2 + (h)) * HTB)
#define PG8_STAGE(bufoff, gbase, voff) do { _Pragma("unroll") for (int _i = 0; _i < 2; ++_i) \
        __builtin_amdgcn_global_load_lds((const unsigned*)((const char*)(gbase) + (voff)[_i]), (LAS unsigned*)(lds + (bufoff) + ldsw + _i * 8192), 16, 0, 0); } while (0)
#define PG8_LDA(dst, b, h) do { _Pragma("unroll") for (int m = 0; m < 4; ++m) _Pragma("unroll") for (int k = 0; k < 2; ++k) dst[m][k] = *(const LAS bf16x8*)(lds + PG8_SA(b, h) + aoff + m * 2048 + k * 1024); } while (0)
#define PG8_LDB(dst, b, h) do { _Pragma("unroll") for (int n = 0; n < 2; ++n) _Pragma("unroll") for (int k = 0; k < 2; ++k) dst[n][k] = *(const LAS bf16x8*)(lds + PG8_SB(b, h) + boff + n * 2048 + k * 1024); } while (0)
#define PG8_MMA(ai, bj, At, Bt) do { __builtin_amdgcn_s_setprio(1); _Pragma("unroll") for (int m = 0; m < 4; ++m) _Pragma("unroll") for (int n = 0; n < 2; ++n) _Pragma("unroll") for (int k = 0; k < 2; ++k) \
        acc[ai][bj][m][n] = __builtin_amdgcn_mfma_f32_16x16x32_bf16(Bt[n][k], At[m][k], acc[ai][bj][m][n], 0, 0, 0); __builtin_amdgcn_s_setprio(0); } while (0)
#define PG8_WAIT_V(n) asm volatile("s_waitcnt vmcnt(" #n ")" ::: "memory")
#define PG8_WAIT_L(n) asm volatile("s_waitcnt lgkmcnt(" #n ")" ::: "memory")
#define PG8_BAR __builtin_amdgcn_s_barrier()
#define PG8_SCHED __builtin_amdgcn_sched_barrier(0)
#define PG8_ABASE(u) ((const char*)g.A + ((size_t)(u).g * g.a_g + (size_t)(u).pm * BM * g.lda) * 2)
#define PG8_BBASE(u) ((const char*)g.Bt + ((size_t)(u).g * g.b_g + (size_t)(u).pn * BM * g.ldb) * 2)
    Unit cur, nxt; int ui = 0;
    if (!S.next(0, cur)) return;
    if constexpr (MODE == 1) { const char* pB = PG8_BBASE(cur); PG8_STAGE(PG8_SB(0, 0), pB, voffB); PG8_STAGE(PG8_SB(0, 1), pB + hstepB, voffB); return; }
    f32x4 acc[2][2][4][2];
    E.init(acc, cur, wr, wc, fr, fq);
    bf16x8 At[4][2], B0[2][2], B1[2][2];
    const char* cA = PG8_ABASE(cur); const char* cB = PG8_BBASE(cur);
    static_assert(SP2, "only the SP2 loop is carried here");
    if constexpr (MODE != 2) { PG8_STAGE(PG8_SB(0, 0), cB, voffB); PG8_STAGE(PG8_SB(0, 1), cB + hstepB, voffB); }
    PG8_STAGE(PG8_SA(0, 0), cA, voffA); PG8_STAGE(PG8_SA(0, 1), cA + hstepA, voffA);
    if (wr == 1) PG8_BAR;
    PG8_WAIT_V(2); PG8_BAR;
    PG8_STAGE(PG8_SB(1, 0), cB + kstep, voffB); PG8_STAGE(PG8_SA(1, 0), cA + kstep, voffA); PG8_STAGE(PG8_SB(1, 1), cB + hstepB + kstep, voffB);
    PG8_WAIT_V(6); PG8_BAR;
    for (;;) {
        const bool has_next = S.next(ui + 1, nxt);
        const char* nA = has_next ? PG8_ABASE(nxt) : cA; const char* nB = has_next ? PG8_BBASE(nxt) : cB;
        for (int t = 0; t < nt; t += 2) {
            const bool last = (t == nt - 2);
            const char* a1 = cA + (size_t)(t + 1) * kstep;
            const char* a2 = last ? nA : cA + (size_t)(t + 2) * kstep; const char* b2 = last ? nB : cB + (size_t)(t + 2) * kstep;
            const char* a3 = a2 + kstep; const char* b3 = b2 + kstep;
            PG8_LDB(B0, 0, 0); PG8_LDB(B1, 0, 1); PG8_SCHED; PG8_LDA(At, 0, 0); PG8_STAGE(PG8_SA(1, 1), a1 + hstepA, voffA);
            PG8_WAIT_V(8); PG8_WAIT_L(0); PG8_BAR; PG8_MMA(0, 0, At, B0); PG8_MMA(0, 1, At, B1); PG8_BAR; PG8_SCHED;
            PG8_LDA(At, 0, 1); PG8_STAGE(PG8_SB(0, 0), b2, voffB); PG8_STAGE(PG8_SB(0, 1), b2 + hstepB, voffB); PG8_STAGE(PG8_SA(0, 0), a2, voffA);
            PG8_WAIT_V(8); PG8_WAIT_L(0); PG8_BAR; PG8_MMA(1, 0, At, B0); PG8_MMA(1, 1, At, B1); PG8_BAR; PG8_SCHED;
            PG8_LDB(B0, 1, 0); PG8_LDB(B1, 1, 1); PG8_SCHED; PG8_LDA(At, 1, 0); PG8_STAGE(PG8_SA(0, 1), a2 + hstepA, voffA);
            PG8_WAIT_V(8); PG8_WAIT_L(0); PG8_BAR; PG8_MMA(0, 0, At, B0); PG8_MMA(0, 1, At, B1); PG8_BAR; PG8_SCHED;
            PG8_LDA(At, 1, 1); PG8_STAGE(PG8_SB(1, 0), b3, voffB); PG8_STAGE(PG8_SB(1, 1), b3 + hstepB, voffB); PG8_STAGE(PG8_SA(1, 0), a3, voffA);
            PG8_WAIT_V(8); PG8_WAIT_L(0); PG8_BAR; PG8_MMA(1, 0, At, B0); PG8_MMA(1, 1, At, B1); PG8_BAR; PG8_SCHED;
        }
        if constexpr (ALIGN_EPI) { if (wr == 0) PG8_BAR; }
        E(acc, cur, wr, wc, fr, fq);
        if (!has_next) break;
        E.init(acc, nxt, wr, wc, fr, fq);
        cur = nxt; cA = nA; cB = nB; ++ui;
        if constexpr (ALIGN_EPI) { if (wr == 1) PG8_BAR; }
    }
    PG8_WAIT_V(0);
    if constexpr (!ALIGN_EPI) { if (wr == 0) PG8_BAR; }
    PG8_BAR;
#undef PG8_SA
#undef PG8_SB
#undef PG8_STAGE
#undef PG8_LDA
#undef PG8_LDB
#undef PG8_MMA
#undef PG8_WAIT_V
#undef PG8_WAIT_L
#undef PG8_BAR
#undef PG8_SCHED
#undef PG8_ABASE
#undef PG8_BBASE
}

typedef const f32x4 (&AccRef)[2][2][4][2];
__device__ __forceinline__ u32x4 pack8(f32x4 v0, f32x4 v1) { u32x4 w; w.x = cvt_pk_bf16(v0[0], v0[1]); w.y = cvt_pk_bf16(v0[2], v0[3]); w.z = cvt_pk_bf16(v1[0], v1[1]); w.w = cvt_pk_bf16(v1[2], v1[3]); return w; }
__device__ __forceinline__ float rstd_of(const float* ssq, int row) { return rsqrtf(ssq[row] * (1.f / D_MODEL) + EPS); }

struct EpiProj0 {
    static constexpr bool PERM = true;
    bf16_t* O; int ldc; const float* ssq;
    __device__ __forceinline__ void init(f32x4 (&acc)[2][2][4][2], const Unit&, int, int, int, int) const {
#pragma unroll
        for (int a = 0; a < 2; ++a)
#pragma unroll
            for (int b = 0; b < 2; ++b)
#pragma unroll
                for (int m = 0; m < 4; ++m)
#pragma unroll
                    for (int n = 0; n < 2; ++n) acc[a][b][m][n] = (f32x4){0.f, 0.f, 0.f, 0.f}; }
    __device__ __forceinline__ void operator()(AccRef acc, const Unit& u, int wr, int wc, int fr, int fq) const {
        const int row0 = u.pm * BM + wr * 64 + fr, col0 = u.pn * BM + wc * 32 + 8 * fq;
        float sv[2][4];
#pragma unroll
        for (int ai = 0; ai < 2; ++ai)
#pragma unroll
            for (int m = 0; m < 4; ++m) sv[ai][m] = ssq[row0 + ai * HALF + m * 16];
#pragma unroll
        for (int ai = 0; ai < 2; ++ai)
#pragma unroll
            for (int m = 0; m < 4; ++m) { const int row = row0 + ai * HALF + m * 16; const float rs = rsqrtf(sv[ai][m] * (1.f / D_MODEL) + EPS); bf16_t* rowp = O + (size_t)row * ldc + col0;
#pragma unroll
                for (int bj = 0; bj < 2; ++bj) *(u32x4*)(rowp + bj * HALF) = pack8(acc[ai][bj][m][0] * rs, acc[ai][bj][m][1] * rs); }
    }
};
struct EpiProj1 {
    static constexpr bool PERM = true;
    bf16_t* US5; bf16_t* QKV; const float* ssq; float* KM; float* KN2;
    __device__ __forceinline__ void init(f32x4 (&acc)[2][2][4][2], const Unit&, int, int, int, int) const {
#pragma unroll
        for (int a = 0; a < 2; ++a)
#pragma unroll
            for (int b = 0; b < 2; ++b)
#pragma unroll
                for (int m = 0; m < 4; ++m)
#pragma unroll
                    for (int n = 0; n < 2; ++n) acc[a][b][m][n] = (f32x4){0.f, 0.f, 0.f, 0.f}; }
    __device__ __forceinline__ void operator()(AccRef acc, const Unit& u, int wr, int wc, int fr, int fq) const {
        const int row0 = u.pm * BM + wr * 64 + fr, col0 = u.pn * BM + wc * 32 + 8 * fq;
        const bool isK = (u.pn == 4 || u.pn == 5);
        f32x4 cs[2][2];
#pragma unroll
        for (int bj = 0; bj < 2; ++bj) { cs[bj][0] = (f32x4){0.f, 0.f, 0.f, 0.f}; cs[bj][1] = (f32x4){0.f, 0.f, 0.f, 0.f}; }
        float sv[2][4];
#pragma unroll
        for (int ai = 0; ai < 2; ++ai)
#pragma unroll
            for (int m = 0; m < 4; ++m) sv[ai][m] = ssq[row0 + ai * HALF + m * 16];
#pragma unroll
        for (int ai = 0; ai < 2; ++ai)
#pragma unroll
            for (int m = 0; m < 4; ++m) { const int row = row0 + ai * HALF + m * 16; const float rs = rsqrtf(sv[ai][m] * (1.f / D_MODEL) + EPS);
#pragma unroll
                for (int bj = 0; bj < 2; ++bj) { const f32x4 v0 = acc[ai][bj][m][0] * rs, v1 = acc[ai][bj][m][1] * rs; const int col = col0 + bj * HALF;
                    bf16_t* dst;
                    if (u.pn < 2) dst = US5 + ((size_t)((row >> 5) * 32 + (col >> 4)) * 640 + (row & 31) * 16 + (col & 15));
                    else dst = QKV + (size_t)row * 1536 + (col - 512);
                    *(u32x4*)dst = pack8(v0, v1);
                    cs[bj][0] += v0; cs[bj][1] += v1;
                    if (isK) { float sq = (v0[0] * v0[0] + v0[1] * v0[1]) + (v0[2] * v0[2] + v0[3] * v0[3]) + (v1[0] * v1[0] + v1[1] * v1[1]) + (v1[2] * v1[2] + v1[3] * v1[3]);
                        sq += __shfl_xor(sq, 16); sq += __shfl_xor(sq, 32);
                        if (fq == 0) atomicAdd(KN2 + (size_t)row * 4 + ((col - 1024) >> 7), sq); } } }
        if (isK) {
#pragma unroll
            for (int bj = 0; bj < 2; ++bj)
#pragma unroll
                for (int n = 0; n < 2; ++n)
#pragma unroll
                    for (int e = 0; e < 4; ++e) { float s = cs[bj][n][e]; s += __shfl_xor(s, 1); s += __shfl_xor(s, 2); s += __shfl_xor(s, 4); s += __shfl_xor(s, 8);
                        if (fr == 0) { const int col = col0 + bj * HALF + 4 * n + e - 1024; const int h = col >> 7, d = col & 127, b = u.pm >> 4, blk = u.pm & 15;
                            atomicAdd(KM + ((size_t)((b * 4 + h) * 16 + blk) * 128 + d), s * (1.f / 256.f)); } }
        }
    }
};
struct EpiResid {
    static constexpr bool PERM = true;
    bf16_t* XB; float* ssq;
    __device__ __forceinline__ void init(f32x4 (&acc)[2][2][4][2], const Unit& u, int wr, int wc, int fr, int fq) const {
        const int row0 = u.pm * BM + wr * 64 + fr, col0 = u.pn * BM + wc * 32 + 8 * fq;
        u32x4 ow[2][4][2];
#pragma unroll
        for (int ai = 0; ai < 2; ++ai)
#pragma unroll
            for (int m = 0; m < 4; ++m)
#pragma unroll
                for (int bj = 0; bj < 2; ++bj) ow[ai][m][bj] = __builtin_nontemporal_load((const u32x4*)(XB + (size_t)(row0 + ai * HALF + m * 16) * D_MODEL + col0 + bj * HALF));
#pragma unroll
        for (int ai = 0; ai < 2; ++ai)
#pragma unroll
            for (int m = 0; m < 4; ++m)
#pragma unroll
                for (int bj = 0; bj < 2; ++bj) { const u32x4 w = ow[ai][m][bj];
                    acc[ai][bj][m][0] = (f32x4){__uint_as_float(w.x << 16), __uint_as_float(w.x & 0xffff0000u), __uint_as_float(w.y << 16), __uint_as_float(w.y & 0xffff0000u)};
                    acc[ai][bj][m][1] = (f32x4){__uint_as_float(w.z << 16), __uint_as_float(w.z & 0xffff0000u), __uint_as_float(w.w << 16), __uint_as_float(w.w & 0xffff0000u)}; } }
    __device__ __forceinline__ void operator()(AccRef acc, const Unit& u, int wr, int wc, int fr, int fq) const {
        const int row0 = u.pm * BM + wr * 64 + fr, col0 = u.pn * BM + wc * 32 + 8 * fq;
#pragma unroll
        for (int ai = 0; ai < 2; ++ai) {
#pragma unroll
            for (int m = 0; m < 4; ++m) { const int row = row0 + ai * HALF + m * 16; const size_t off = (size_t)row * D_MODEL + col0; float sq = 0.f;
#pragma unroll
                for (int bj = 0; bj < 2; ++bj) { const f32x4 v0 = acc[ai][bj][m][0], v1 = acc[ai][bj][m][1];
                    *(u32x4*)(XB + off + bj * HALF) = pack8(v0, v1);
                    sq += (v0[0] * v0[0] + v0[1] * v0[1]) + (v0[2] * v0[2] + v0[3] * v0[3]) + (v1[0] * v1[0] + v1[1] * v1[1]) + (v1[2] * v1[2] + v1[3] * v1[3]); }
                sq += __shfl_xor(sq, 16); sq += __shfl_xor(sq, 32);
                if (fq == 0) atomicAdd(ssq + row, sq); }
        }
    }
};
struct EpiFinal {
    static constexpr bool PERM = true;
    const bf16_t* XB; float* ssq; unsigned* cnt; const float* gfin; float* out; bool onexcc;
    __device__ __forceinline__ void init(f32x4 (&acc)[2][2][4][2], const Unit& u, int wr, int wc, int fr, int fq) const {
        const int row0 = u.pm * BM + wr * 64 + fr, col0 = u.pn * BM + wc * 32 + 8 * fq;
        u32x4 ow[2][4][2];
#pragma unroll
        for (int ai = 0; ai < 2; ++ai)
#pragma unroll
            for (int m = 0; m < 4; ++m)
#pragma unroll
                for (int bj = 0; bj < 2; ++bj) ow[ai][m][bj] = __builtin_nontemporal_load((const u32x4*)(XB + (size_t)(row0 + ai * HALF + m * 16) * D_MODEL + col0 + bj * HALF));
#pragma unroll
        for (int ai = 0; ai < 2; ++ai)
#pragma unroll
            for (int m = 0; m < 4; ++m)
#pragma unroll
                for (int bj = 0; bj < 2; ++bj) { const u32x4 w = ow[ai][m][bj];
                    acc[ai][bj][m][0] = (f32x4){__uint_as_float(w.x << 16), __uint_as_float(w.x & 0xffff0000u), __uint_as_float(w.y << 16), __uint_as_float(w.y & 0xffff0000u)};
                    acc[ai][bj][m][1] = (f32x4){__uint_as_float(w.z << 16), __uint_as_float(w.z & 0xffff0000u), __uint_as_float(w.w << 16), __uint_as_float(w.w & 0xffff0000u)}; } }
    __device__ __forceinline__ void operator()(f32x4 (&acc)[2][2][4][2], const Unit& u, int wr, int wc, int fr, int fq) const {
        const int row0 = u.pm * BM + wr * 64 + fr, col0 = u.pn * BM + wc * 32 + 8 * fq;
#pragma unroll
        for (int ai = 0; ai < 2; ++ai) {
#pragma unroll
            for (int m = 0; m < 4; ++m) { const int row = row0 + ai * HALF + m * 16; float sq = 0.f;
#pragma unroll
                for (int bj = 0; bj < 2; ++bj) { const f32x4 v0 = acc[ai][bj][m][0], v1 = acc[ai][bj][m][1];
                    sq += (v0[0] * v0[0] + v0[1] * v0[1]) + (v0[2] * v0[2] + v0[3] * v0[3]) + (v1[0] * v1[0] + v1[1] * v1[1]) + (v1[2] * v1[2] + v1[3] * v1[3]); }
                sq += __shfl_xor(sq, 16); sq += __shfl_xor(sq, 32);
                if (fq == 0) atomicAdd(ssq + row, sq); }
        }
        asm volatile("s_waitcnt vmcnt(0) lgkmcnt(0)" ::: "memory"); __builtin_amdgcn_s_barrier(); asm volatile("" ::: "memory");
        if (threadIdx.x == 0) {
            unsigned* c = cnt + 64 * u.pm;
            if (onexcc) {
                const unsigned old = __hip_atomic_fetch_add(c, 1u, __ATOMIC_RELAXED, __HIP_MEMORY_SCOPE_AGENT);
                if (old + 1u == 4u) { __builtin_amdgcn_fence(__ATOMIC_RELEASE, "agent"); asm volatile("s_waitcnt vmcnt(0)" ::: "memory"); (void)__hip_atomic_fetch_add(c + 1, 1u, __ATOMIC_RELAXED, __HIP_MEMORY_SCOPE_AGENT); }
                unsigned sp = 0u;
                while (__hip_atomic_load(c + 1, __ATOMIC_RELAXED, __HIP_MEMORY_SCOPE_AGENT) == 0u) { __builtin_amdgcn_s_sleep(1); if (++sp > (1u << 22)) break; }
            } else {
                __builtin_amdgcn_fence(__ATOMIC_RELEASE, "agent");
                asm volatile("s_waitcnt vmcnt(0)" ::: "memory");
                (void)__hip_atomic_fetch_add(c, 1u, __ATOMIC_RELAXED, __HIP_MEMORY_SCOPE_AGENT);
                unsigned sp = 0u;
                while (__hip_atomic_load(c, __ATOMIC_RELAXED, __HIP_MEMORY_SCOPE_AGENT) < 4u) { __builtin_amdgcn_s_sleep(1); if (++sp > (1u << 22)) break; }
            }
            __builtin_amdgcn_fence(__ATOMIC_ACQUIRE, "agent");
            asm volatile("s_waitcnt vmcnt(0)" ::: "memory");
        }
        asm volatile("s_waitcnt vmcnt(0) lgkmcnt(0)" ::: "memory"); __builtin_amdgcn_s_barrier(); asm volatile("" ::: "memory");
        f32x4 gv[2][2];
#pragma unroll
        for (int bj = 0; bj < 2; ++bj) { gv[bj][0] = *(const f32x4*)(gfin + col0 + bj * HALF); gv[bj][1] = *(const f32x4*)(gfin + col0 + bj * HALF + 4); }
        float sv[2][4];
#pragma unroll
        for (int ai = 0; ai < 2; ++ai)
#pragma unroll
            for (int m = 0; m < 4; ++m) sv[ai][m] = __hip_atomic_load(ssq + row0 + ai * HALF + m * 16, __ATOMIC_RELAXED, __HIP_MEMORY_SCOPE_AGENT);
#pragma unroll
        for (int ai = 0; ai < 2; ++ai)
#pragma unroll
            for (int m = 0; m < 4; ++m) { const int row = row0 + ai * HALF + m * 16; const float rs = rsqrtf(sv[ai][m] * (1.f / D_MODEL) + EPS); float* op = out + (size_t)row * D_MODEL + col0;
#pragma unroll
                for (int bj = 0; bj < 2; ++bj) { __builtin_nontemporal_store(acc[ai][bj][m][0] * rs * gv[bj][0], (f32x4*)(op + bj * HALF)); __builtin_nontemporal_store(acc[ai][bj][m][1] * rs * gv[bj][1], (f32x4*)(op + bj * HALF + 4)); } }
    }
};
struct EpiSwiglu {
    static constexpr bool PERM = true;
    bf16_t* H; const float* ssq;
    __device__ __forceinline__ void init(f32x4 (&acc)[2][2][4][2], const Unit&, int, int, int, int) const {
#pragma unroll
        for (int a = 0; a < 2; ++a)
#pragma unroll
            for (int b = 0; b < 2; ++b)
#pragma unroll
                for (int m = 0; m < 4; ++m)
#pragma unroll
                    for (int n = 0; n < 2; ++n) acc[a][b][m][n] = (f32x4){0.f, 0.f, 0.f, 0.f}; }
    __device__ __forceinline__ void operator()(AccRef acc, const Unit& u, int wr, int wc, int fr, int fq) const {
        const int row0 = u.pm * BM + wr * 64 + fr, col0 = u.pn * HALF + wc * 32 + 8 * fq;
        float sv[2][4];
#pragma unroll
        for (int ai = 0; ai < 2; ++ai)
#pragma unroll
            for (int m = 0; m < 4; ++m) sv[ai][m] = ssq[row0 + ai * HALF + m * 16];
#pragma unroll
        for (int ai = 0; ai < 2; ++ai)
#pragma unroll
            for (int m = 0; m < 4; ++m) { const int row = row0 + ai * HALF + m * 16; const float rs = rsqrtf(sv[ai][m] * (1.f / D_MODEL) + EPS);
                f32x4 hv[2];
#pragma unroll
                for (int n = 0; n < 2; ++n) { const f32x4 g = acc[ai][0][m][n] * rs, uu = acc[ai][1][m][n] * rs;
#pragma unroll
                    for (int e = 0; e < 4; ++e) hv[n][e] = g[e] * fast_sigmoid(g[e]) * uu[e]; }
                *(u32x4*)(H + (size_t)row * FFN + col0) = pack8(hv[0], hv[1]); }
    }
};
struct EpiXE {
    static constexpr bool PERM = false;
    float* XE;
    __device__ __forceinline__ void init(f32x4 (&acc)[2][2][4][2], const Unit&, int, int, int, int) const {
#pragma unroll
        for (int a = 0; a < 2; ++a)
#pragma unroll
            for (int b = 0; b < 2; ++b)
#pragma unroll
                for (int m = 0; m < 4; ++m)
#pragma unroll
                    for (int n = 0; n < 2; ++n) acc[a][b][m][n] = (f32x4){0.f, 0.f, 0.f, 0.f}; }
    __device__ __forceinline__ void operator()(AccRef acc, const Unit& u, int wr, int wc, int fr, int fq) const {
        const int row0 = u.pm * BM + wr * 64 + fr, col0 = wc * 32 + 4 * fq;
#pragma unroll
        for (int ai = 0; ai < 2; ++ai)
#pragma unroll
            for (int m = 0; m < 4; ++m) { const int J = row0 + ai * HALF + m * 16; float* dst = XE + ((size_t)J * 32 + u.g) * 128 + col0;
#pragma unroll
                for (int n = 0; n < 2; ++n) *(f32x4*)(dst + 16 * n) = acc[ai][0][m][n]; }
    }
};
struct EpiS5Y {
    static constexpr bool PERM = true;
    const bf16_t* US5; const float* dskip; bf16_t* YG;
    __device__ __forceinline__ void init(f32x4 (&acc)[2][2][4][2], const Unit& u, int wr, int wc, int fr, int fq) const {
        const int row0 = u.pm * BM + wr * 64 + fr, col0 = u.pn * BM + wc * 32 + 8 * fq;
        u32x4 uv[2][4][2]; f32x4 dv[2][2];
#pragma unroll
        for (int bj = 0; bj < 2; ++bj) { const int p0 = (col0 + bj * HALF) & 15; dv[bj][0] = *(const f32x4*)(dskip + u.g * 16 + p0); dv[bj][1] = *(const f32x4*)(dskip + u.g * 16 + p0 + 4); }
#pragma unroll
        for (int ai = 0; ai < 2; ++ai)
#pragma unroll
            for (int m = 0; m < 4; ++m)
#pragma unroll
                for (int bj = 0; bj < 2; ++bj) { const int col = col0 + bj * HALF; uv[ai][m][bj] = *(const u32x4*)(US5 + ((size_t)(row0 + ai * HALF + m * 16) * 32 + u.g) * 640 + (col >> 4) * 16 + (col & 15)); }
#pragma unroll
        for (int ai = 0; ai < 2; ++ai)
#pragma unroll
            for (int m = 0; m < 4; ++m)
#pragma unroll
                for (int bj = 0; bj < 2; ++bj) { const u32x4 uw = uv[ai][m][bj]; const f32x4 d0 = dv[bj][0], d1 = dv[bj][1];
                    acc[ai][bj][m][0] = (f32x4){d0[0] * __uint_as_float(uw.x << 16), d0[1] * __uint_as_float(uw.x & 0xffff0000u), d0[2] * __uint_as_float(uw.y << 16), d0[3] * __uint_as_float(uw.y & 0xffff0000u)};
                    acc[ai][bj][m][1] = (f32x4){d1[0] * __uint_as_float(uw.z << 16), d1[1] * __uint_as_float(uw.z & 0xffff0000u), d1[2] * __uint_as_float(uw.w << 16), d1[3] * __uint_as_float(uw.w & 0xffff0000u)}; } }
    __device__ __forceinline__ void operator()(AccRef acc, const Unit& u, int wr, int wc, int fr, int fq) const {
        const int row0 = u.pm * BM + wr * 64 + fr, col0 = u.pn * BM + wc * 32 + 8 * fq;
#pragma unroll
        for (int ai = 0; ai < 2; ++ai)
#pragma unroll
            for (int m = 0; m < 4; ++m) { const int J = row0 + ai * HALF + m * 16;
#pragma unroll
                for (int bj = 0; bj < 2; ++bj) { const int col = col0 + bj * HALF, tau = col >> 4, p0 = col & 15;
                    f32x4 y0 = acc[ai][bj][m][0], y1 = acc[ai][bj][m][1];
#pragma unroll
                    for (int e = 0; e < 4; ++e) { y0[e] = gelu_tanh_fast(y0[e]); y1[e] = gelu_tanh_fast(y1[e]); }
                    *(u32x4*)(YG + ((size_t)J * 32 + tau) * 512 + u.g * 16 + p0) = pack8(y0, y1); } }
    }
};
struct EpiGlu {
    static constexpr bool PERM = true;
    const bf16_t* YG; const float* bias; bf16_t* MIX;
    __device__ __forceinline__ void init(f32x4 (&acc)[2][2][4][2], const Unit&, int, int, int, int) const {
#pragma unroll
        for (int a = 0; a < 2; ++a)
#pragma unroll
            for (int b = 0; b < 2; ++b)
#pragma unroll
                for (int m = 0; m < 4; ++m)
#pragma unroll
                    for (int n = 0; n < 2; ++n) acc[a][b][m][n] = (f32x4){0.f, 0.f, 0.f, 0.f}; }
    __device__ __forceinline__ void operator()(AccRef acc, const Unit& u, int wr, int wc, int fr, int fq) const {
        const int row0 = u.pm * BM + wr * 64 + fr, col0 = u.pn * BM + wc * 32 + 8 * fq;
#pragma unroll
        for (int ai = 0; ai < 2; ++ai) {
        u32x4 yv[4][2];
#pragma unroll
            for (int m = 0; m < 4; ++m)
#pragma unroll
                for (int bj = 0; bj < 2; ++bj) yv[m][bj] = *(const u32x4*)(YG + (size_t)(row0 + ai * HALF + m * 16) * 512 + col0 + bj * HALF);
#pragma unroll
            for (int m = 0; m < 4; ++m) { const int row = row0 + ai * HALF + m * 16;
#pragma unroll
                for (int bj = 0; bj < 2; ++bj) { const int col = col0 + bj * HALF;
                    const u32x4 yw = yv[m][bj];
                    const f32x4 b0 = *(const f32x4*)(bias + col), b1 = *(const f32x4*)(bias + col + 4);
                    const f32x4 a0 = acc[ai][bj][m][0] + b0, a1 = acc[ai][bj][m][1] + b1;
                    f32x4 o0, o1;
                    o0[0] = __uint_as_float(yw.x << 16) * fast_sigmoid(a0[0]); o0[1] = __uint_as_float(yw.x & 0xffff0000u) * fast_sigmoid(a0[1]);
                    o0[2] = __uint_as_float(yw.y << 16) * fast_sigmoid(a0[2]); o0[3] = __uint_as_float(yw.y & 0xffff0000u) * fast_sigmoid(a0[3]);
                    o1[0] = __uint_as_float(yw.z << 16) * fast_sigmoid(a1[0]); o1[1] = __uint_as_float(yw.z & 0xffff0000u) * fast_sigmoid(a1[1]);
                    o1[2] = __uint_as_float(yw.w << 16) * fast_sigmoid(a1[2]); o1[3] = __uint_as_float(yw.w & 0xffff0000u) * fast_sigmoid(a1[3]);
                    *(u32x4*)(MIX + (size_t)row * D_MODEL + col) = pack8(o0, o1); } }
        }
    }
};
}


namespace sbp {
typedef float f32x16 __attribute__((ext_vector_type(16)));
typedef short s16x4 __attribute__((ext_vector_type(4)));
typedef short v4i16_t __attribute__((ext_vector_type(4)));
__device__ __forceinline__ int crow(int r, int hi) { return (r & 3) + 8 * (r >> 2) + 4 * hi; }
__device__ __forceinline__ s16x4 vtr(LAS const unsigned char* p) { return __builtin_bit_cast(s16x4, __builtin_amdgcn_ds_read_tr16_b64_v4i16((LAS v4i16_t*)p)); }

template <bool DIAG>
__device__ __forceinline__ void sb_weights(const f32x16& p0, const f32x16& p1, int tl  , int hi, float& carry, bf16x8 (&pf)[4]) {
    const float C = 0.125f * 1.4426950408889634f;
    float e[32], rr[32];
#pragma unroll
    for (int i = 0; i < 32; ++i) { const float a = (i < 16) ? p0[i & 15] : p1[i & 15];
        float ev = __builtin_amdgcn_exp2f(fminf(a * C, 80.f)); float rv = __builtin_amdgcn_rcpf(1.f + ev);
        if (DIAG) { const int kidx = (i >> 4) * 32 + crow(i & 15, hi); const bool valid = kidx < tl; ev = valid ? ev : 0.f; rv = valid ? rv : 1.f; }
        e[i] = ev; rr[i] = rv; }
    float T[8];
#pragma unroll
    for (int g = 0; g < 8; ++g) { const float s3 = rr[4 * g + 3], s2 = rr[4 * g + 2] * s3, s1 = rr[4 * g + 1] * s2, s0 = rr[4 * g] * s1;
        e[4 * g + 3] *= s3; e[4 * g + 2] *= s2; e[4 * g + 1] *= s1; e[4 * g] *= s0; T[g] = s0; }
    float run = carry;
#pragma unroll
    for (int g = 7; g >= 0; --g) { auto sw = __builtin_amdgcn_permlane32_swap(__float_as_uint(T[g]), __float_as_uint(T[g]), false, false);
        const float T0 = __uint_as_float(sw[0]), T1 = __uint_as_float(sw[1]);
        const float off1 = run, off0 = run * T1; run = off0 * T0; const float off = hi ? off1 : off0;
        e[4 * g] *= off; e[4 * g + 1] *= off; e[4 * g + 2] *= off; e[4 * g + 3] *= off; }
    carry = run;
#pragma unroll
    for (int s = 0; s < 4; ++s) { u32x4 w; w.x = cvt_pk_bf16(e[8 * s], e[8 * s + 1]); w.y = cvt_pk_bf16(e[8 * s + 2], e[8 * s + 3]); w.z = cvt_pk_bf16(e[8 * s + 4], e[8 * s + 5]); w.w = cvt_pk_bf16(e[8 * s + 6], e[8 * s + 7]);
        pf[s] = __builtin_bit_cast(bf16x8, w); }
}

__device__ __forceinline__ unsigned sb_unit(const bf16_t* __restrict__ PROJ, bf16_t* __restrict__ MIX, int b, int h, int qt, LAS unsigned char* vl, int lane, unsigned* qw) {
    const int r32 = lane & 31, hi = lane >> 5;
    const size_t rowbase = (size_t)b * SEQ;
    const int t = qt * 32 + r32;
    const bf16_t* qp = PROJ + (rowbase + t) * 2560 + 1024 + h * 64 + hi * 8;
    const bf16_t* kg = PROJ + rowbase * 2560 + 1536 + h * 64;
    const bf16_t* vg = PROJ + rowbase * 2560 + 2048 + h * 64;
    const unsigned ksrc = (unsigned)((lane >> 3) * 2560 + (((lane & 7) ^ (lane >> 3)) * 8));
    const unsigned vsrc = (unsigned)((lane >> 2) * 2560 + (lane & 3) * 8);
#define SB_DMA_K(k0_) do { _Pragma("unroll") for (int i_ = 0; i_ < 8; ++i_) \
        __builtin_amdgcn_global_load_lds((const unsigned*)(kg + (size_t)((k0_) + 8 * i_) * 2560 + ksrc), (LAS unsigned*)(vl + i_ * 1024), 16, 0, 0); } while (0)
#define SB_DMA_V(k0_) do { _Pragma("unroll") for (int i_ = 0; i_ < 8; ++i_) \
        __builtin_amdgcn_global_load_lds((const unsigned*)(vg + (size_t)((k0_) + 16 * (i_ & 3)) * 2560 + 32 * (i_ >> 2) + vsrc), (LAS unsigned*)(vl + 8192 + i_ * 1024), 16, 0, 0); } while (0)
    asm volatile("s_waitcnt vmcnt(8)" ::: "memory");
    const int kt0 = qt >> 1;
    SB_DMA_K(kt0 * 64); SB_DMA_V(kt0 * 64);
    bf16x8 qf[4];
#pragma unroll
    for (int ks = 0; ks < 4; ++ks) qf[ks] = *(const bf16x8*)(qp + 16 * ks);
    f32x16 o0, o1;
#pragma unroll
    for (int r = 0; r < 16; ++r) { o0[r] = 0.f; o1[r] = 0.f; }
    float carry = 1.f;
    LAS const unsigned char* vrd = vl + 8192 + (4 * hi + ((lane & 15) >> 2)) * 64 + ((lane >> 4) & 1) * 32 + (lane & 3) * 8;
    for (int kt = kt0; kt >= 0; --kt) {
        const int k0 = kt * 64;
        asm volatile("s_waitcnt vmcnt(8)" ::: "memory");
        f32x16 p0, p1;
#pragma unroll
        for (int r = 0; r < 16; ++r) { p0[r] = 0.f; p1[r] = 0.f; }
        __builtin_amdgcn_s_setprio(1);
#pragma unroll
        for (int ks = 0; ks < 4; ++ks) { const int c = 2 * ks + hi;
            const bf16x8 ka = *(LAS const bf16x8*)(vl + r32 * 128 + ((c ^ (r32 & 7)) << 4)), kb = *(LAS const bf16x8*)(vl + (32 + r32) * 128 + ((c ^ (r32 & 7)) << 4));
            p0 = __builtin_amdgcn_mfma_f32_32x32x16_bf16(ka, qf[ks], p0, 0, 0, 0); p1 = __builtin_amdgcn_mfma_f32_32x32x16_bf16(kb, qf[ks], p1, 0, 0, 0); }
        __builtin_amdgcn_s_setprio(0);
        asm volatile("s_waitcnt lgkmcnt(0)" ::: "memory");
        if (kt > 0) SB_DMA_K(k0 - 64);
        bf16x8 pf[4];
        if (kt == kt0) sb_weights<true>(p0, p1, t - k0, hi, carry, pf); else sb_weights<false>(p0, p1, t - k0, hi, carry, pf);
        if (kt > 0) asm volatile("s_waitcnt vmcnt(8)" ::: "memory"); else asm volatile("s_waitcnt vmcnt(0)" ::: "memory");
        __builtin_amdgcn_s_setprio(1);
#pragma unroll
        for (int s = 0; s < 4; ++s) {
            const s16x4 a0 = vtr(vrd + s * 1024), a1 = vtr(vrd + s * 1024 + 512), c0 = vtr(vrd + 4096 + s * 1024), c1 = vtr(vrd + 4096 + s * 1024 + 512);
            const bf16x8 va = (bf16x8){a0[0], a0[1], a0[2], a0[3], a1[0], a1[1], a1[2], a1[3]}, vc = (bf16x8){c0[0], c0[1], c0[2], c0[3], c1[0], c1[1], c1[2], c1[3]};
            o0 = __builtin_amdgcn_mfma_f32_32x32x16_bf16(va, pf[s], o0, 0, 0, 0);
            o1 = __builtin_amdgcn_mfma_f32_32x32x16_bf16(vc, pf[s], o1, 0, 0, 0);
        }
        __builtin_amdgcn_s_setprio(0);
        asm volatile("s_waitcnt lgkmcnt(0)" ::: "memory");
        if (__all(carry < 1e-9f)) break;
        if (kt > 0) SB_DMA_V(k0 - 64);
    }
    unsigned nx = 0u; if (lane == 0) nx = atomicAdd(qw, 1u);
    bf16_t* op = MIX + (rowbase + t) * D_MODEL + 512 + h * 64 + 4 * hi;
#pragma unroll
    for (int g = 0; g < 4; ++g) {
        unsigned long long w0 = (unsigned long long)cvt_pk_bf16(o0[4 * g], o0[4 * g + 1]) | ((unsigned long long)cvt_pk_bf16(o0[4 * g + 2], o0[4 * g + 3]) << 32);
        unsigned long long w1 = (unsigned long long)cvt_pk_bf16(o1[4 * g], o1[4 * g + 1]) | ((unsigned long long)cvt_pk_bf16(o1[4 * g + 2], o1[4 * g + 3]) << 32);
        *(unsigned long long*)(op + 8 * g) = w0; *(unsigned long long*)(op + 32 + 8 * g) = w1; }
#undef SB_DMA_K
#undef SB_DMA_V
    return (unsigned)__builtin_amdgcn_readfirstlane((int)nx);
}
}


#define XB_TMO      128
#define XB_XCNT(j)  (256  + 64 * (j))
#define XB_XSUB(j)  (1280 + 64 * (j))
#define XB_XGEN(j)  (2304 + 64 * (j))
#define XB_TOP      3328
#define XB_TOPGEN   3392
#define XCD_BAR_WORDS 3456
#define XB_SPIN_CAP (1u << 18)
__device__ __forceinline__ unsigned xb_ld(unsigned* p)              { return __hip_atomic_load(p, __ATOMIC_RELAXED, __HIP_MEMORY_SCOPE_AGENT); }
__device__ __forceinline__ unsigned xb_add(unsigned* p, unsigned v) { return __hip_atomic_fetch_add(p, v, __ATOMIC_RELAXED, __HIP_MEMORY_SCOPE_AGENT); }
__device__ __forceinline__ unsigned xb_xcc_id() { return (unsigned)__builtin_amdgcn_s_getreg((3 << 11) | 20) & 0xFu; }
#define XB_SPIN(cond, bar) do { unsigned _sp = 0; while (cond) { __builtin_amdgcn_s_sleep(1); \
    if ((++_sp & 255u) == 0u) { if (xb_ld(&(bar)[XB_TMO])) break; if (_sp > XB_SPIN_CAP) { atomicAdd(&(bar)[XB_TMO], 1u); break; } } } } while (0)
struct XcdBarrier { unsigned* bar; unsigned x; volatile LAS unsigned* st; };
__device__ __forceinline__ XcdBarrier xcd_barrier_post(unsigned* bar, volatile LAS unsigned* st) {
    XcdBarrier b; b.bar = bar; b.x = xb_xcc_id(); b.st = st;
    if (threadIdx.x == 0) (void)xb_add(&bar[XB_XCNT(b.x)], 1u);
    return b;
}
__device__ __forceinline__ void xcd_barrier_complete(unsigned* bar, unsigned x, unsigned& nloc, unsigned& nx) {
    const unsigned G = gridDim.x * gridDim.y * gridDim.z;
    unsigned sum, cnt, mine, sp = 0u;
    for (;;) {
        sum = 0u; cnt = 0u; mine = 0u;
#pragma unroll
        for (unsigned j = 0; j < 16; ++j) { const unsigned c = xb_ld(&bar[XB_XCNT(j)]); sum += c; cnt += (c > 0u) ? 1u : 0u; mine = (j == x) ? c : mine; }
        if (sum == G) break;
        __builtin_amdgcn_s_sleep(1);
        if ((++sp & 255u) == 0u) { if (xb_ld(&bar[XB_TMO])) break; if (sp > XB_SPIN_CAP) { atomicAdd(&bar[XB_TMO], 1u); break; } }
    }
    nloc = mine > 0u ? mine : 1u; nx = cnt > 0u ? cnt : 1u;
}
__device__ __forceinline__ void xcd_barrier(const XcdBarrier& b) {
    asm volatile("s_waitcnt vmcnt(0)" ::: "memory");
    __syncthreads();
    if (threadIdx.x == 0) {
        unsigned* bar = b.bar;
        __builtin_amdgcn_s_waitcnt(0);
        unsigned nloc = b.st[0], nx = b.st[1];
        if (nloc == 0u) { xcd_barrier_complete(bar, b.x, nloc, nx); b.st[0] = nloc; b.st[1] = nx; }
        const unsigned old = xb_add(&bar[XB_XSUB(b.x)], 1u);
        const unsigned gen = old / nloc;
        if (old + 1u == (gen + 1u) * nloc) {
            __builtin_amdgcn_fence(__ATOMIC_RELEASE, "agent");
            asm volatile("s_waitcnt vmcnt(0)" ::: "memory");
            const unsigned og = xb_add(&bar[XB_TOP], 1u);
            const unsigned tg = og / nx;
            if (og + 1u == (tg + 1u) * nx) xb_add(&bar[XB_TOPGEN], 1u);
            else XB_SPIN(xb_ld(&bar[XB_TOPGEN]) == tg, bar);
            __builtin_amdgcn_fence(__ATOMIC_ACQUIRE, "agent");
            xb_add(&bar[XB_XGEN(b.x)], 1u);
            asm volatile("s_waitcnt vmcnt(0)" ::: "memory");
        } else {
            XB_SPIN(xb_ld(&bar[XB_XGEN(b.x)]) == gen, bar);
            __builtin_amdgcn_fence(__ATOMIC_ACQUIRE, "agent");
            asm volatile("s_waitcnt vmcnt(0)" ::: "memory");
        }
    }
    __syncthreads();
}

__device__ __forceinline__ void sub_barrier(unsigned* ctr, unsigned n) {
    asm volatile("s_waitcnt vmcnt(0)" ::: "memory");
    __syncthreads();
    if (threadIdx.x == 0) {
        __builtin_amdgcn_fence(__ATOMIC_RELEASE, "agent");
        asm volatile("s_waitcnt vmcnt(0)" ::: "memory");
        (void)xb_add(ctr, 1u);
        unsigned sp = 0u;
        while (xb_ld(ctr) < n) { __builtin_amdgcn_s_sleep(2); if (++sp > (1u << 22)) break; }
        __builtin_amdgcn_fence(__ATOMIC_ACQUIRE, "agent");
        asm volatile("s_waitcnt vmcnt(0)" ::: "memory");
    }
    __syncthreads();
}

__device__ __forceinline__ void sub_barrier_sh(unsigned* loc, unsigned nloc, unsigned* glob, unsigned nglob) {
    asm volatile("s_waitcnt vmcnt(0)" ::: "memory");
    __syncthreads();
    if (threadIdx.x == 0) {
        const unsigned old = xb_add(loc, 1u);
        if (old + 1u == nloc) { __builtin_amdgcn_fence(__ATOMIC_RELEASE, "agent"); asm volatile("s_waitcnt vmcnt(0)" ::: "memory"); (void)xb_add(glob, 1u); }
        unsigned sp = 0u;
        while (xb_ld(glob) < nglob) { __builtin_amdgcn_s_sleep(2); if (++sp > (1u << 22)) break; }
        __builtin_amdgcn_fence(__ATOMIC_ACQUIRE, "agent");
        asm volatile("s_waitcnt vmcnt(0)" ::: "memory");
    }
    __syncthreads();
}

struct NoPre { __device__ __forceinline__ void operator()() const {} };
template <class Pre = NoPre>
__device__ __forceinline__ void fam_barrier(unsigned* ctr, unsigned n, unsigned* glob = nullptr, const Pre& pre = Pre()) {
    asm volatile("s_waitcnt vmcnt(0)" ::: "memory");
    __syncthreads();
    pre();
    if (threadIdx.x == 0) {
        const unsigned old = xb_add(ctr, 1u);
        if (glob == nullptr) {
            if (old + 1u == n) (void)xb_add(ctr + 1, 1u);
            else { unsigned sp = 0u; while (xb_ld(ctr + 1) == 0u) { __builtin_amdgcn_s_sleep(1); if (++sp > (1u << 22)) break; } }
        } else {
            if (old + 1u == n) (void)xb_add(glob, 1u);
            asm volatile("buffer_inv sc1" ::: "memory");
            unsigned sp = 0u; while (xb_ld(glob) < 8u) { __builtin_amdgcn_s_sleep(1); if (++sp > (1u << 22)) break; }
            asm volatile("s_waitcnt vmcnt(0)" ::: "memory");
        }
    }
    __syncthreads();
}

constexpr int NWAVES = 8;
constexpr int RING_BYTES = 131072, LDS_BYTES = 147456;
constexpr int NPHASE = 14;
struct Args { const float* in[29]; float* out; unsigned char* ws; int ph_lo, ph_hi; };


namespace mbp {
typedef float f32x16 __attribute__((ext_vector_type(16)));
typedef short s16x4 __attribute__((ext_vector_type(4)));
constexpr int D = 128, NW = 8, QBLK = 32, KVBLK = 64, LD = 1536;
constexpr float SCALE = 0.088388347648318440f;
constexpr float THR = 8.f;
constexpr float NEG = -1e30f;
constexpr size_t SHM_V = KVBLK * D * 2, SHM_K = KVBLK * D * 2, SHM_ATTN = 2 * SHM_V + 2 * SHM_K + NW * 64 * 4 + 64;
#define KSWZ(row, colB) ((row) * 256 + ((colB) ^ (((row) & 7) << 4)))
#define SBAR() __builtin_amdgcn_sched_barrier(0)
__device__ __forceinline__ int crow(int r, int hi) { return (r & 3) + 8 * (r >> 2) + 4 * hi; }
__device__ __forceinline__ unsigned cvtpk(float lo, float hi) { unsigned r; asm volatile("v_cvt_pk_bf16_f32 %0, %1, %2" : "=v"(r) : "v"(lo), "v"(hi)); return r; }

__device__ __forceinline__ void partialSM(f32x16& p0, f32x16& p1, float& m_reg, float& mn, float& alpha) {
    constexpr float C = SCALE * 1.4426950408889634f;
    float pmax = p0[0];
#pragma unroll
    for (int r = 1; r < 16; ++r) pmax = fmaxf(pmax, p0[r]);
#pragma unroll
    for (int r = 0; r < 16; ++r) pmax = fmaxf(pmax, p1[r]);
    { auto rr = __builtin_amdgcn_permlane32_swap(__float_as_uint(pmax), __float_as_uint(pmax), false, false);
      pmax = fmaxf(__uint_as_float(rr[0]), __uint_as_float(rr[1])); }
    if (__builtin_expect(__all(pmax - m_reg <= THR / SCALE), 1)) { mn = m_reg; alpha = 1.f; }
    else { mn = fmaxf(m_reg, pmax); alpha = __builtin_amdgcn_exp2f((m_reg - mn) * C); m_reg = mn; }
    const float mnC = -mn * C;
#pragma unroll
    for (int r = 0; r < 16; ++r) p0[r] = fmaf(p0[r], C, mnC);
#pragma unroll
    for (int r = 0; r < 16; ++r) p1[r] = fmaf(p1[r], C, mnC);
#pragma unroll
    for (int r = 0; r < 16; ++r) p0[r] = __builtin_amdgcn_exp2f(p0[r]);
}
__device__ __forceinline__ void finishSM(f32x16& p0, f32x16& p1, float alpha, float& l_reg, bf16x8& pa0, bf16x8& pa1, bf16x8& pa2, bf16x8& pa3) {
#pragma unroll
    for (int r = 0; r < 16; ++r) p1[r] = __builtin_amdgcn_exp2f(p1[r]);
    float ps = 0;
#pragma unroll
    for (int r = 0; r < 16; ++r) ps += p0[r];
#pragma unroll
    for (int r = 0; r < 16; ++r) ps += p1[r];
    { auto rr = __builtin_amdgcn_permlane32_swap(__float_as_uint(ps), __float_as_uint(ps), false, false);
      ps = __uint_as_float(rr[0]) + __uint_as_float(rr[1]); }
    l_reg = l_reg * alpha + ps;
#define PK4(P, BASE, OUT) do { unsigned a0 = cvtpk(P[BASE + 0], P[BASE + 1]), a1 = cvtpk(P[BASE + 2], P[BASE + 3]);   \
    unsigned b0 = cvtpk(P[BASE + 4], P[BASE + 5]), b1 = cvtpk(P[BASE + 6], P[BASE + 7]);                              \
    auto r0 = __builtin_amdgcn_permlane32_swap(a0, b0, false, false); auto r1 = __builtin_amdgcn_permlane32_swap(a1, b1, false, false); \
    u32x4 w = {r0[0], r1[0], r0[1], r1[1]}; OUT = *reinterpret_cast<bf16x8*>(&w); } while (0)
    PK4(p0, 0, pa0); PK4(p0, 8, pa1); PK4(p1, 0, pa2); PK4(p1, 8, pa3);
#undef PK4
}
__device__ __forceinline__ void qkt(f32x16& p0, f32x16& p1, const bf16_t* Ks, const bf16x8* qr, int r32, int hi, float base, float cs) {
    const char* kb = (const char*)Ks;
#define KRD(d0) *reinterpret_cast<const bf16x8*>(kb + KSWZ(r32, ((d0) * 16 + hi * 8) * 2))
#define KRD2(d0) *reinterpret_cast<const bf16x8*>(kb + KSWZ(32 + r32, ((d0) * 16 + hi * 8) * 2))
    bf16x8 ka[3], kc[3];
    ka[0] = KRD(0); kc[0] = KRD2(0); ka[1] = KRD(1); kc[1] = KRD2(1);
#pragma unroll
    for (int r = 0; r < 16; ++r) { p0[r] = fmaf(cs, (float)((r & 3) + 8 * (r >> 2)), base); p1[r] = fmaf(cs, (float)(32 + (r & 3) + 8 * (r >> 2)), base); }
    SBAR();
#pragma unroll
    for (int d0 = 0; d0 < 8; ++d0) {
        if (d0 + 2 < 8) { ka[(d0 + 2) % 3] = KRD(d0 + 2); kc[(d0 + 2) % 3] = KRD2(d0 + 2); }
        SBAR();
        p0 = __builtin_amdgcn_mfma_f32_32x32x16_bf16(ka[d0 % 3], qr[d0], p0, 0, 0, 0);
        p1 = __builtin_amdgcn_mfma_f32_32x32x16_bf16(kc[d0 % 3], qr[d0], p1, 0, 0, 0);
        SBAR();
    }
#undef KRD
#undef KRD2
}
__device__ __forceinline__ int v_st(int k, int c) { const int kk = (k & ~0xC) | ((k & 4) << 1) | ((k & 8) >> 1); return ((kk >> 3) * 4 + (c >> 5)) * 512 + ((kk & 7) * 32 + (c & 31)) * 2; }
__device__ __forceinline__ int v_rd_base(int lane) { return ((lane & 3) << 3) | (((lane >> 2) & 3) << 6) | (((lane >> 4) & 1) << 5) | (((lane >> 5) & 1) << 8); }
constexpr int v_rd_off(int d0, int ks, int half) { return d0 * 512 + ks * 4096 + half * 2048; }
template <int OFF> __device__ __forceinline__ s16x4 tr_read(int vb) { s16x4 r; asm volatile("ds_read_b64_tr_b16 %0, %1 offset:%2" : "=&v"(r) : "v"(vb), "i"(OFF) : "memory"); return r; }
template <int D0> __device__ __forceinline__ void pv_one(f32x16& od, int vb, bf16x8 pa0, bf16x8 pa1, bf16x8 pa2, bf16x8 pa3) {
    const s16x4 l0 = tr_read<v_rd_off(D0, 0, 0)>(vb), h0 = tr_read<v_rd_off(D0, 0, 1)>(vb), l1 = tr_read<v_rd_off(D0, 1, 0)>(vb), h1 = tr_read<v_rd_off(D0, 1, 1)>(vb);
    const s16x4 l2 = tr_read<v_rd_off(D0, 2, 0)>(vb), h2 = tr_read<v_rd_off(D0, 2, 1)>(vb), l3 = tr_read<v_rd_off(D0, 3, 0)>(vb), h3 = tr_read<v_rd_off(D0, 3, 1)>(vb);
    asm volatile("s_waitcnt lgkmcnt(0)" ::: "memory"); SBAR();
#define PK(L, H) (bf16x8){L[0], L[1], L[2], L[3], H[0], H[1], H[2], H[3]}
    od = __builtin_amdgcn_mfma_f32_32x32x16_bf16(pa0, PK(l0, h0), od, 0, 0, 0);
    od = __builtin_amdgcn_mfma_f32_32x32x16_bf16(pa1, PK(l1, h1), od, 0, 0, 0);
    od = __builtin_amdgcn_mfma_f32_32x32x16_bf16(pa2, PK(l2, h2), od, 0, 0, 0);
    od = __builtin_amdgcn_mfma_f32_32x32x16_bf16(pa3, PK(l3, h3), od, 0, 0, 0);
#undef PK
}
struct VFrag { s16x4 l0, h0, l1, h1, l2, h2, l3, h3; };
typedef short v4i16m_t __attribute__((ext_vector_type(4)));
template <int OFF> __device__ __forceinline__ s16x4 tr_rd(int vb) { return __builtin_bit_cast(s16x4, __builtin_amdgcn_ds_read_tr16_b64_v4i16((LAS v4i16m_t*)(unsigned)(vb + OFF))); }
template <int D0> __device__ __forceinline__ void v_reads(VFrag& f, int vb) {
    f.l0 = tr_rd<v_rd_off(D0, 0, 0)>(vb); f.h0 = tr_rd<v_rd_off(D0, 0, 1)>(vb); f.l1 = tr_rd<v_rd_off(D0, 1, 0)>(vb); f.h1 = tr_rd<v_rd_off(D0, 1, 1)>(vb);
    f.l2 = tr_rd<v_rd_off(D0, 2, 0)>(vb); f.h2 = tr_rd<v_rd_off(D0, 2, 1)>(vb); f.l3 = tr_rd<v_rd_off(D0, 3, 0)>(vb); f.h3 = tr_rd<v_rd_off(D0, 3, 1)>(vb);
}
__device__ __forceinline__ void v_mma(f32x16& od, const VFrag& f, bf16x8 pa0, bf16x8 pa1, bf16x8 pa2, bf16x8 pa3) {
#define PK(L, H) (bf16x8){L[0], L[1], L[2], L[3], H[0], H[1], H[2], H[3]}
    od = __builtin_amdgcn_mfma_f32_32x32x16_bf16(pa0, PK(f.l0, f.h0), od, 0, 0, 0);
    od = __builtin_amdgcn_mfma_f32_32x32x16_bf16(pa1, PK(f.l1, f.h1), od, 0, 0, 0);
    od = __builtin_amdgcn_mfma_f32_32x32x16_bf16(pa2, PK(f.l2, f.h2), od, 0, 0, 0);
    od = __builtin_amdgcn_mfma_f32_32x32x16_bf16(pa3, PK(f.l3, f.h3), od, 0, 0, 0);
#undef PK
}
__device__ __forceinline__ void pv_d0_pre(f32x16* o, int vb, VFrag& fa, bf16x8 pa0, bf16x8 pa1, bf16x8 pa2, bf16x8 pa3) {
    VFrag fb;
    v_reads<1>(fb, vb); SBAR(); v_mma(o[0], fa, pa0, pa1, pa2, pa3); SBAR();
    v_reads<2>(fa, vb); SBAR(); v_mma(o[1], fb, pa0, pa1, pa2, pa3); SBAR();
    v_reads<3>(fb, vb); SBAR(); v_mma(o[2], fa, pa0, pa1, pa2, pa3); SBAR();
    v_mma(o[3], fb, pa0, pa1, pa2, pa3);
}
__device__ __forceinline__ void pv_d0(f32x16* o, int vb, bf16x8 pa0, bf16x8 pa1, bf16x8 pa2, bf16x8 pa3) {
    pv_one<0>(o[0], vb, pa0, pa1, pa2, pa3); pv_one<1>(o[1], vb, pa0, pa1, pa2, pa3); pv_one<2>(o[2], vb, pa0, pa1, pa2, pa3); pv_one<3>(o[3], vb, pa0, pa1, pa2, pa3);
}

constexpr int SLOT_BYTES = 32768, NSLOT = 4, OFF_WSF = NSLOT * SLOT_BYTES, OFF_NEED = OFF_WSF + NW * 64 * 4;
__device__ __forceinline__ void moba_unit(const bf16_t* __restrict__ QKV, const float* __restrict__ KM, const float* __restrict__ KN2, bf16_t* __restrict__ MIX, int b, int h, int qb, char* lds, LAS unsigned char* ldsL, unsigned* qw, volatile LAS unsigned* uq) {
    const int tid = threadIdx.x, wid = __builtin_amdgcn_readfirstlane(tid >> 6), lane = tid & 63, r32 = lane & 31, hi = lane >> 5;
    float* wsf = (float*)(lds + OFF_WSF) + wid * 64; float* li_l = wsf; float* al_l = wsf + 32;
    unsigned* need_l = (unsigned*)(lds + OFF_NEED);
    const size_t rowbase = (size_t)b * SEQ; const int q0 = qb * 256;
    const bf16_t* Qb = QKV + (rowbase + q0) * LD + h * D;
    const bf16_t* Kh = QKV + rowbase * LD + 512 + h * D;
    const bf16_t* Vh = QKV + rowbase * LD + 1024 + h * D;
    float m_reg = NEG, l_reg = 0; f32x16 o[4];
#pragma unroll
    for (int d = 0; d < 4; ++d)
#pragma unroll
        for (int r = 0; r < 16; ++r) o[d][r] = 0.f;
    bf16x8 qr[8];
    const bf16_t* Qw = Qb + (size_t)(wid * QBLK + r32) * LD + hi * 8;
#pragma unroll
    for (int d0 = 0; d0 < 8; ++d0) qr[d0] = *reinterpret_cast<const bf16x8*>(Qw + d0 * 16);
    unsigned sel = 0u;
    if (qb > 0) {
        f32x16 gs;
#pragma unroll
        for (int r = 0; r < 16; ++r) gs[r] = 0.f;
        const float* km = KM + ((size_t)((b * 4 + h) * 16 + (r32 & 15)) * 128) + hi * 8;
        const bool rowok = r32 < qb;
#pragma unroll
        for (int d0 = 0; d0 < 8; ++d0) { f32x4 k0v = *(const f32x4*)(km + d0 * 16), k1v = *(const f32x4*)(km + d0 * 16 + 4);
            if (!rowok) { k0v = (f32x4){0.f, 0.f, 0.f, 0.f}; k1v = k0v; }
            u32x4 whi, wlo; float rem[8];
            whi.x = pk2(k0v[0], k0v[1]); whi.y = pk2(k0v[2], k0v[3]); whi.z = pk2(k1v[0], k1v[1]); whi.w = pk2(k1v[2], k1v[3]);
            rem[0] = k0v[0] - __uint_as_float(whi.x << 16); rem[1] = k0v[1] - __uint_as_float(whi.x & 0xffff0000u);
            rem[2] = k0v[2] - __uint_as_float(whi.y << 16); rem[3] = k0v[3] - __uint_as_float(whi.y & 0xffff0000u);
            rem[4] = k1v[0] - __uint_as_float(whi.z << 16); rem[5] = k1v[1] - __uint_as_float(whi.z & 0xffff0000u);
            rem[6] = k1v[2] - __uint_as_float(whi.w << 16); rem[7] = k1v[3] - __uint_as_float(whi.w & 0xffff0000u);
            wlo.x = pk2(rem[0], rem[1]); wlo.y = pk2(rem[2], rem[3]); wlo.z = pk2(rem[4], rem[5]); wlo.w = pk2(rem[6], rem[7]);
            gs = __builtin_amdgcn_mfma_f32_32x32x16_bf16(__builtin_bit_cast(bf16x8, whi), qr[d0], gs, 0, 0, 0);
            gs = __builtin_amdgcn_mfma_f32_32x32x16_bf16(__builtin_bit_cast(bf16x8, wlo), qr[d0], gs, 0, 0, 0); }
        float G[16];
#pragma unroll
        for (int r = 0; r < 8; ++r) { auto sw = __builtin_amdgcn_permlane32_swap(__float_as_uint(gs[r]), __float_as_uint(gs[r]), false, false);
            G[(r & 3) + 8 * (r >> 2)] = __uint_as_float(sw[0]); G[(r & 3) + 8 * (r >> 2) + 4] = __uint_as_float(sw[1]); }
#pragma unroll
        for (int rep = 0; rep < 3; ++rep) { int bi = -1; float bv = -INFINITY;
#pragma unroll
            for (int j = 0; j < 16; ++j) if (j < qb && !((sel >> j) & 1u) && (bi < 0 || G[j] > bv)) { bi = j; bv = G[j]; }
            if (bi >= 0) sel |= 1u << bi; }
    }
    float qn2 = 0.f;
#pragma unroll
    for (int d0 = 0; d0 < 8; ++d0) { const u32x4 w = __builtin_bit_cast(u32x4, qr[d0]);
        const float a0 = __uint_as_float(w.x << 16), a1 = __uint_as_float(w.x & 0xffff0000u), a2 = __uint_as_float(w.y << 16), a3 = __uint_as_float(w.y & 0xffff0000u);
        const float a4 = __uint_as_float(w.z << 16), a5 = __uint_as_float(w.z & 0xffff0000u), a6 = __uint_as_float(w.w << 16), a7 = __uint_as_float(w.w & 0xffff0000u);
        qn2 += (a0 * a0 + a1 * a1) + (a2 * a2 + a3 * a3) + (a4 * a4 + a5 * a5) + (a6 * a6 + a7 * a7); }
    { auto sw = __builtin_amdgcn_permlane32_swap(__float_as_uint(qn2), __float_as_uint(qn2), false, false); qn2 = __uint_as_float(sw[0]) + __uint_as_float(sw[1]); }
    float kn2 = 0.f;
    for (int sx = tid; sx < q0 + 256; sx += 512) kn2 = fmaxf(kn2, KN2[(rowbase + sx) * 4 + h]);
    __syncthreads();
    if (tid == 0) { need_l[0] = 0u; need_l[2] = 0u; need_l[3] = 0u; }
    __syncthreads();
    if (sel) atomicOr(need_l, sel);
    atomicMax(need_l + 2, __float_as_uint(kn2)); atomicMax(need_l + 3, __float_as_uint(qn2));
    __syncthreads();
    const unsigned need = (unsigned)__builtin_amdgcn_readfirstlane((int)need_l[0]);
    const float slope = (h == 0) ? 0.25f : (h == 1) ? 0.0625f : (h == 2) ? 0.015625f : 0.00390625f;
    const float smax = sqrtf(__uint_as_float((unsigned)__builtin_amdgcn_readfirstlane((int)need_l[2])) * __uint_as_float((unsigned)__builtin_amdgcn_readfirstlane((int)need_l[3]))) * SCALE * 1.02f;
    const float dthr = (2.f * smax + 30.f) / slope;
    unsigned long long blist = (unsigned long long)qb; int nblk = 1;
    for (int j = qb - 1; j >= 0; --j) if (((need >> j) & 1u) && !((float)(q0 - 256 * j - 255) > dthr)) { blist |= (unsigned long long)j << (4 * nblk); ++nblk; }
    nblk = __builtin_amdgcn_readfirstlane(nblk);
    const int NT = 4 * nblk;
    const int tq = q0 + wid * QBLK + r32;
    const float cs = slope / SCALE;
#define TILE_BLK(n) ((int)((blist >> (4 * ((n) >> 2))) & 15ull))
#define TILE_K0(n) (TILE_BLK(n) * 256 + ((n) & 3) * KVBLK)
    unsigned ksrc[2], vsrc[2];
#pragma unroll
    for (int i = 0; i < 2; ++i) { const int ci = (wid * 2 + i) * 64 + lane; const int row = ci >> 4, c = (ci & 15) ^ (row & 7); ksrc[i] = (unsigned)(row * LD + c * 8);
        const int st = ci >> 5, rr = (ci & 31) >> 2, cc = ci & 3; const int kk = (st >> 2) * 8 + rr; const int k = (kk & ~0xC) | ((kk & 4) << 1) | ((kk & 8) >> 1);
        vsrc[i] = (unsigned)(k * LD + (st & 3) * 32 + cc * 8); }
#define DMA_TILE(n, slot) do { const int k0_ = TILE_K0(n); const bf16_t* kg_ = Kh + (size_t)k0_ * LD; const bf16_t* vg_ = Vh + (size_t)k0_ * LD; \
    _Pragma("unroll") for (int i_ = 0; i_ < 2; ++i_) { \
        __builtin_amdgcn_global_load_lds((const unsigned*)(kg_ + ksrc[i_]), (LAS unsigned*)(ldsL + (slot) * SLOT_BYTES + (wid * 2 + i_) * 1024), 16, 0, 0); \
        __builtin_amdgcn_global_load_lds((const unsigned*)(vg_ + vsrc[i_]), (LAS unsigned*)(ldsL + (slot) * SLOT_BYTES + 16384 + (wid * 2 + i_) * 1024), 16, 0, 0); } } while (0)
    const int vb0 = (int)(uintptr_t)lds + 16384 + v_rd_base(lane);
    DMA_TILE(0, 0); DMA_TILE(1, 1);
    int slot = 0; bool pend = false; int pslot = 0; bf16x8 pa0, pa1, pa2, pa3;
    asm volatile("s_waitcnt vmcnt(4)" ::: "memory");
    if (wid >= 4) __builtin_amdgcn_s_barrier();
    for (int t = 0; t < NT; ++t) {
        if (t + 1 < NT) asm volatile("s_waitcnt vmcnt(4)" ::: "memory"); else asm volatile("s_waitcnt vmcnt(0)" ::: "memory");
        __builtin_amdgcn_s_barrier();
        if (t + 2 < NT) { const int s2 = (slot + 2) & 3; DMA_TILE(t + 2, s2); }
        const int blk = TILE_BLK(t), k0 = blk * 256 + (t & 3) * KVBLK;
        const bool own = (t >> 2) == 0;
        const bool allowed = own || ((sel >> blk) & 1u);
        const bool skip = own ? (k0 > q0 + wid * QBLK + QBLK - 1) : !__any(allowed);
        f32x16 p0, p1;
        __builtin_amdgcn_s_setprio(1);
        VFrag fa;
        if (pend) { v_reads<0>(fa, vb0 + pslot * SLOT_BYTES); }
        if (!skip) {
            const float base = fmaf(-cs, (float)(tq - k0 - 4 * hi), allowed ? 0.f : NEG);
            qkt(p0, p1, (const bf16_t*)(lds + slot * SLOT_BYTES), qr, r32, hi, base, cs);
        }
        if (pend) pv_d0_pre(o, vb0 + pslot * SLOT_BYTES, fa, pa0, pa1, pa2, pa3);
        __builtin_amdgcn_s_setprio(0);
        pend = !skip;
        if (t + 2 < NT) asm volatile("s_waitcnt vmcnt(4)" ::: "memory"); else asm volatile("s_waitcnt vmcnt(0)" ::: "memory");
        asm volatile("s_waitcnt lgkmcnt(0)" ::: "memory");
        __builtin_amdgcn_s_barrier();
        if (!skip) {
            float mn, alpha;
            if (__builtin_amdgcn_readfirstlane((int)(own && k0 + 63 > q0 + wid * QBLK))) {
                asm volatile("" ::: "memory");
#pragma unroll
                for (int r = 0; r < 16; ++r) { const int kv = k0 + crow(r, hi); if (kv > tq) p0[r] = NEG; if (kv + 32 > tq) p1[r] = NEG; } }
            partialSM(p0, p1, m_reg, mn, alpha);
            finishSM(p0, p1, alpha, l_reg, pa0, pa1, pa2, pa3);
            if (__any(alpha < 1.f)) { if (hi == 0) al_l[r32] = alpha; asm volatile("s_waitcnt lgkmcnt(0)" ::: "memory");
#pragma unroll
                for (int d = 0; d < 4; ++d)
#pragma unroll
                    for (int r = 0; r < 16; ++r) o[d][r] *= al_l[crow(r, hi)]; }
            pslot = slot;
        }
        slot = (slot + 1) & 3;
    }
    if (wid < 4) __builtin_amdgcn_s_barrier();
    if (pend) pv_d0(o, vb0 + pslot * SLOT_BYTES, pa0, pa1, pa2, pa3);
    if (hi == 0) li_l[r32] = l_reg; asm volatile("s_waitcnt lgkmcnt(0)" ::: "memory");
    float rli[16];
#pragma unroll
    for (int r = 0; r < 16; ++r) rli[r] = __builtin_amdgcn_rcpf(li_l[crow(r, hi)]);
    unsigned nxu = 0u; if (tid == 0) nxu = atomicAdd(qw, 1u);
    bf16_t* Ow = MIX + (rowbase + q0 + wid * QBLK) * D_MODEL + 512 + h * D;
#pragma unroll
    for (int r = 0; r < 16; ++r) { const int orow = crow(r, hi);
#pragma unroll
        for (int d0 = 0; d0 < 4; ++d0) Ow[(size_t)orow * D_MODEL + d0 * 32 + r32] = (bf16_t)f2bf(o[d0][r] * rli[r]); }
    if (tid == 0) uq[0] = nxu;
#undef TILE_BLK
#undef TILE_K0
#undef DMA_TILE
}
#undef KSWZ
#undef SBAR
}

namespace rgp {
typedef float f32x16 __attribute__((ext_vector_type(16)));
constexpr int XS_BYTES = 33 * 1024;
constexpr int OFF_XS = 0;
constexpr int OFF_GS = 2 * XS_BYTES;
constexpr int OFF_WL = OFF_GS + 32768;
constexpr int OFF_CW = OFF_WL + 32768;
constexpr int OFF_SM = OFF_CW + 1280;
__device__ __forceinline__ float lo16(unsigned w) { return __uint_as_float(w << 16); }
__device__ __forceinline__ float hi16(unsigned w) { return __uint_as_float(w & 0xffff0000u); }
#define RG_LBAR() do { asm volatile("s_waitcnt lgkmcnt(0)" ::: "memory"); __builtin_amdgcn_s_barrier(); asm volatile("" ::: "memory"); } while (0)

__device__ __forceinline__ void rg_unit(const Args& a, const bf16_t* __restrict__ PROJ, bf16_t* __restrict__ MIX, int b, int hd, int jb, LAS unsigned char* lds) {
    const int tid = threadIdx.x, lane = tid & 63, wave = __builtin_amdgcn_readfirstlane(tid >> 6), r32 = lane & 31, hi = lane >> 5;
    const float* conv_w = a.in[3]; const float* conv_b = a.in[4]; const float* wa = a.in[5]; const float* ba = a.in[6];
    const float* wx = a.in[7]; const float* bx = a.in[8]; const float* lam = a.in[9];
    const size_t rowbase = (size_t)b * SEQ;
    typedef float f32x2 __attribute__((ext_vector_type(2)));
    LAS f32x2* SM = (LAS f32x2*)(lds + OFF_SM);
    __syncthreads();
    { const int gate = tid >> 8, ks = (tid >> 6) & 3, h2 = (tid >> 5) & 1, j = tid & 31;
      const float* W = (gate ? wx : wa) + ((size_t)(hd * 64 + 16 * ks + 8 * h2) * 64 + 32 * jb + j);
      float v[8];
#pragma unroll
      for (int e = 0; e < 8; ++e) v[e] = W[e * 64];
#pragma unroll
      for (int k = 0; k < 4; ++k) { const float* cwp = conv_w + k * 512 + hd * 64 + 16 * ks + 8 * h2; float t[8];
#pragma unroll
          for (int e = 0; e < 8; ++e) t[e] = v[e] * cwp[e];
          u32x4 o; o.x = pk2(t[0], t[1]); o.y = pk2(t[2], t[3]); o.z = pk2(t[4], t[5]); o.w = pk2(t[6], t[7]);
          *(LAS u32x4*)(lds + OFF_WL + (k * 512 + tid) * 16) = o; } }
    const int cj = hd * 64 + 32 * jb + r32;
    float cwk[4];
#pragma unroll
    for (int k = 0; k < 4; ++k) cwk[k] = conv_w[k * 512 + cj];
    const float cbj = conv_b[cj]; float baj = ba[cj], bxj = bx[cj];
    { const float* Wa = wa + (size_t)(hd * 64) * 64 + 32 * jb + r32; const float* Wx = wx + (size_t)(hd * 64) * 64 + 32 * jb + r32; const float* cbh = conv_b + hd * 64;
#pragma unroll 16
      for (int c = 0; c < 64; ++c) { const float cbv = cbh[c]; baj = fmaf(Wa[c * 64], cbv, baj); bxj = fmaf(Wx[c * 64], cbv, bxj); } }
    const float lj = lam[cj];
    const float c8sp = -8.f * 1.4426950408889634f * (fmaxf(-lj, 0.f) + log1pf(expf(-fabsf(lj))));
    const unsigned xsrc = (unsigned)((lane >> 3) * 2560 + (((lane & 7) ^ (lane >> 3)) * 8));
    const unsigned gsrc = (unsigned)((lane >> 2) * 2560 + (lane & 3) * 8);
    const bf16_t* xg0 = PROJ + (rowbase) * 2560 + hd * 64;
    const bf16_t* gg0 = PROJ + (rowbase) * 2560 + 512 + hd * 64 + 32 * jb;
#define RG_DMA(st_, par_) do { \
    for (int i_ = wave; i_ < 33; i_ += 8) __builtin_amdgcn_global_load_lds((const unsigned*)(xg0 + (ptrdiff_t)(256 * (st_) - 3 + 8 * i_) * 2560 + xsrc), (LAS unsigned*)(lds + OFF_XS + (par_) * XS_BYTES + i_ * 1024), 16, 0, 0); \
    _Pragma("unroll") for (int i_ = 0; i_ < 2; ++i_) __builtin_amdgcn_global_load_lds((const unsigned*)(gg0 + (size_t)(256 * (st_) + 16 * (wave * 2 + i_)) * 2560 + gsrc), (LAS unsigned*)(lds + OFF_GS + (par_) * 16384 + (wave * 2 + i_) * 1024), 16, 0, 0); } while (0)
    float STc = 0.f;
    RG_DMA(0, 0);
    for (int st = 0; st < 16; ++st) {
        const int par = st & 1;
        LAS const unsigned char* xs = lds + OFF_XS + par * XS_BYTES;
        asm volatile("s_waitcnt vmcnt(0)" ::: "memory"); RG_LBAR();
        if (st + 1 < 16) RG_DMA(st + 1, par ^ 1);
        const bool first = (st == 0);
        f32x16 ga, gx;
#pragma unroll
        for (int r = 0; r < 16; ++r) { ga[r] = baj; gx[r] = bxj; }
#pragma unroll
        for (int k = 0; k < 4; ++k)
#pragma unroll
            for (int ks = 0; ks < 4; ++ks) { const int row = 32 * wave + r32 + k;
                u32x4 xv = *(LAS const u32x4*)(xs + row * 128 + (((2 * ks + hi) ^ (row & 7)) << 4));
                if (first && row < 3) xv = (u32x4){0u, 0u, 0u, 0u};
                const bf16x8 w0 = *(LAS const bf16x8*)(lds + OFF_WL + (k * 512 + ((0 * 4 + ks) * 2 + hi) * 32 + r32) * 16);
                const bf16x8 w1 = *(LAS const bf16x8*)(lds + OFF_WL + (k * 512 + ((1 * 4 + ks) * 2 + hi) * 32 + r32) * 16);
                ga = __builtin_amdgcn_mfma_f32_32x32x16_bf16(__builtin_bit_cast(bf16x8, xv), w0, ga, 0, 0, 0);
                gx = __builtin_amdgcn_mfma_f32_32x32x16_bf16(__builtin_bit_cast(bf16x8, xv), w1, gx, 0, 0, 0); }
        float hl[16], Pl[16], inH[4], inA[4];
        float cumA = 1.f, cumH = 0.f;
        const int cch = (32 * jb + r32) >> 3, cwi = (r32 & 7) * 2;
#pragma unroll
        for (int g = 0; g < 4; ++g) {
            float xv[7];
#pragma unroll
            for (int m = 0; m < 7; ++m) { const int row = 32 * wave + 8 * g + 4 * hi + m;
                xv[m] = bf2f(*(LAS const bf16_t*)(xs + row * 128 + ((cch ^ (row & 7)) << 4) + cwi)); if (first && row < 3) xv[m] = 0.f; }
            float A_ = 1.f, H_ = 0.f;
#pragma unroll
            for (int i = 0; i < 4; ++i) { const int r = 4 * g + i;
                const float xc = cbj + cwk[0] * xv[i] + cwk[1] * xv[i + 1] + cwk[2] * xv[i + 2] + cwk[3] * xv[i + 3];
                const float rg = fast_sigmoid(ga[r]), ig = fast_sigmoid(gx[r]);
                const float la2 = c8sp * rg; const float av = __builtin_amdgcn_exp2f(la2);
                const float x2 = la2 * 1.3862943611198906f;
                const float om = (x2 > -0.25f) ? -x2 * (1.f + x2 * (0.5f + x2 * (0.16666667f + x2 * (0.041666668f + x2 * 0.0083333338f)))) : 1.f - av * av;
                const float bv = __builtin_amdgcn_sqrtf(om) * ig * xc;
                H_ = av * H_ + bv; A_ = av * A_; hl[r] = H_; Pl[r] = A_; }
            auto swA = __builtin_amdgcn_permlane32_swap(__float_as_uint(A_), __float_as_uint(A_), false, false);
            auto swH = __builtin_amdgcn_permlane32_swap(__float_as_uint(H_), __float_as_uint(H_), false, false);
            const float A0 = __uint_as_float(swA[0]), A1 = __uint_as_float(swA[1]), H0 = __uint_as_float(swH[0]), H1 = __uint_as_float(swH[1]);
            const float in1H = A0 * cumH + H0, in1A = A0 * cumA;
            inH[g] = hi ? in1H : cumH; inA[g] = hi ? in1A : cumA;
            cumH = A1 * in1H + H1; cumA = A1 * in1A; }
        if (hi == 0) SM[(par * 8 + wave) * 32 + r32] = (f32x2){cumA, cumH};
        RG_LBAR();
        float xst = STc, myHin = 0.f;
#pragma unroll
        for (int w2 = 0; w2 < 8; ++w2) { const f32x2 sm = SM[(par * 8 + w2) * 32 + r32]; if (w2 == wave) myHin = xst; xst = sm.x * xst + sm.y; }
        STc = xst;
#pragma unroll
        for (int g = 0; g < 4; ++g) { const float inT = inH[g] + inA[g] * myHin;
#pragma unroll
            for (int i = 0; i < 4; ++i) { const int r = 4 * g + i, tt = 8 * g + 4 * hi + i;
                const float h = hl[r] + Pl[r] * inT;
                LAS bf16_t* gp = (LAS bf16_t*)(lds + OFF_GS + par * 16384 + (32 * wave + tt) * 64 + r32 * 2);
                const float gt = bf2f(*gp); *gp = (bf16_t)f2bf(h * gelu_tanh_fast(gt)); } }
        RG_LBAR();
        for (int i = tid; i < 1024; i += 512) { const int row = i >> 2, ch = i & 3;
            *(u32x4*)(MIX + (rowbase + 256 * st + row) * D_MODEL + hd * 64 + 32 * jb + ch * 8) = *(LAS const u32x4*)(lds + OFF_GS + par * 16384 + row * 64 + ch * 16); }
    }
    asm volatile("s_waitcnt vmcnt(0)" ::: "memory");
    __syncthreads();
#undef RG_DMA
}
#undef RG_LBAR
}

__device__ __forceinline__ void p0_transpose_item(const float* W, int K, int N, bf16_t* WT, const float* sc, int mode, LAS float* scr, int item, int lane) {
    const int nblk = N / 32, kb = item / nblk, nb = item % nblk, k0 = 64 * kb, n0 = 32 * nb;
    f32x4 v[8];
#pragma unroll
    for (int i = 0; i < 8; ++i) { const int kk = 8 * i + (lane >> 3); v[i] = __builtin_nontemporal_load((const f32x4*)(W + (size_t)(k0 + kk) * N + n0 + (lane & 7) * 4)); }
#pragma unroll
    for (int i = 0; i < 8; ++i) { const int kk = 8 * i + (lane >> 3); f32x4 w = v[i]; if (sc) w = w * sc[k0 + kk];
        LAS float* d = scr + kk * 33 + (lane & 7) * 4; d[0] = w[0]; d[1] = w[1]; d[2] = w[2]; d[3] = w[3]; }
    asm volatile("s_waitcnt lgkmcnt(0)" ::: "memory");
    const int c = lane & 7;
    const int rbase = (mode == 0) ? n0 : ((n0 >> 7) * 256 + (mode == 2 ? 128 : 0) + (n0 & 127));
#pragma unroll
    for (int j = 0; j < 4; ++j) { const int n = (lane >> 3) + 8 * j; const LAS float* s = scr + (8 * c) * 33 + n;
        u32x4 o; o.x = pk2(s[0 * 33], s[1 * 33]); o.y = pk2(s[2 * 33], s[3 * 33]); o.z = pk2(s[4 * 33], s[5 * 33]); o.w = pk2(s[6 * 33], s[7 * 33]);
        *(u32x4*)(WT + (size_t)(rbase + n) * K + k0 + 8 * c) = o; }
    asm volatile("s_waitcnt lgkmcnt(0)" ::: "memory");
}
struct TrJob { const float* W; int K, N; bf16_t* WT; const float* sc; int mode; int items; };

__device__ __forceinline__ void p0_s5_ops(const Args& a, LAS unsigned char* lds, int g, int q8) {
    typedef float f32x2 __attribute__((ext_vector_type(2)));
    LAS f32x2* pw = (LAS f32x2*)lds;
    LAS f32x2* Bb = (LAS f32x2*)(lds + 33 * 64 * 8);
    LAS f32x2* Cc = (LAS f32x2*)(lds + 33 * 64 * 8 + 8192);
    LAS float* Kt = (LAS float*)(lds + 33 * 64 * 8 + 16384);
    const int tid = threadIdx.x;
    const float* lam_re = a.in[13]; const float* lam_im = a.in[14]; const float* log_dt = a.in[15];
    const float* b_re = a.in[16]; const float* b_im = a.in[17]; const float* c_re = a.in[18]; const float* c_im = a.in[19];
    bf16_t* Eg = (bf16_t*)(a.ws + WS_E) + (size_t)g * 256 * 512;
    bf16_t* TCg = (bf16_t*)(a.ws + WS_TC) + (size_t)g * 512 * 640;
    __syncthreads();
    if (tid < 64) {
        const int n = tid;
        const double dt = exp((double)log_dt[g]), lr = (double)lam_re[g * 64 + n], li = (double)lam_im[g * 64 + n];
        const double mag = exp(lr * dt); double sn, cs; sincos(li * dt, &sn, &cs);
        const double are = mag * cs, aim = mag * sn;
        const double den = lr * lr + li * li, nr = are - 1.0, ni = aim;
        const double fre = (nr * lr + ni * li) / den, fim = (ni * lr - nr * li) / den;
        double pr = 1.0, pi = 0.0;
        for (int d = 0; d <= 32; ++d) { pw[d * 64 + n] = (f32x2){(float)pr, (float)pi}; const double t = pr * are - pi * aim; pi = pr * aim + pi * are; pr = t; }
        if (q8 == 0) { const f32x2 v = pw[32 * 64 + n]; float* A32 = (float*)(a.ws + WS_A32); A32[(g * 64 + n) * 2] = v.x; A32[(g * 64 + n) * 2 + 1] = v.y; }
        for (int p = 0; p < 16; ++p) { const double br = (double)b_re[(g * 64 + n) * 16 + p], bi = (double)b_im[(g * 64 + n) * 16 + p];
            Bb[n * 16 + p] = (f32x2){(float)(fre * br - fim * bi), (float)(fre * bi + fim * br)}; }
    }
    for (int i = tid; i < 1024; i += 512) { const int p = i >> 6, n = i & 63; Cc[p * 64 + n] = (f32x2){c_re[(g * 16 + p) * 64 + n], c_im[(g * 16 + p) * 64 + n]}; }
    __syncthreads();
    for (int i = tid; i < 1024; i += 512) { const int dd = i >> 8, p = (i >> 4) & 15, pp = i & 15; const int d = 4 * q8 + dd; float s = 0.f;
        for (int n = 0; n < 64; ++n) { const f32x2 w = pw[d * 64 + n], b = Bb[n * 16 + pp], c = Cc[p * 64 + n];
            const float wr_ = w.x * b.x - w.y * b.y, wi_ = w.x * b.y + w.y * b.x; s += c.x * wr_ - c.y * wi_; }
        Kt[i] = s; }
    __syncthreads();
    for (int i = tid; i < 4 * 32 * 32; i += 512) { const int dd = i >> 10, tau = (i >> 5) & 31, p = (i >> 1) & 15, pp0 = (i & 1) * 8; const int d = 4 * q8 + dd, sx = tau - d;
        if (sx >= 0) { const LAS float* k = Kt + (dd * 16 + p) * 16 + pp0; u32x4 o; o.x = pk2(k[0], k[1]); o.y = pk2(k[2], k[3]); o.z = pk2(k[4], k[5]); o.w = pk2(k[6], k[7]);
            *(u32x4*)(TCg + (size_t)(tau * 16 + p) * 640 + sx * 16 + pp0) = o; } }
    for (int i = tid; i < 64 * 64; i += 512) { const int rl = i >> 6, ch = i & 63; const int tau = 4 * q8 + (rl >> 4), p = rl & 15, sx = ch >> 1, pp0 = (ch & 1) * 8;
        if (sx > tau) *(u32x4*)(TCg + (size_t)(tau * 16 + p) * 640 + sx * 16 + pp0) = (u32x4){0u, 0u, 0u, 0u}; }
    for (int i = tid; i < 64 * 16; i += 512) { const int rl = i >> 4, ch = i & 15; const int tau = 4 * q8 + (rl >> 4), p = rl & 15; float v[8];
#pragma unroll
        for (int e = 0; e < 8; ++e) { const int c = ch * 8 + e, n = c & 63; const f32x2 w = pw[(tau + 1) * 64 + n], cc = Cc[p * 64 + n];
            v[e] = (c < 64) ? (cc.x * w.x - cc.y * w.y) : -(cc.x * w.y + cc.y * w.x); }
        u32x4 o; o.x = pk2(v[0], v[1]); o.y = pk2(v[2], v[3]); o.z = pk2(v[4], v[5]); o.w = pk2(v[6], v[7]);
        *(u32x4*)(TCg + (size_t)(tau * 16 + p) * 640 + 512 + ch * 8) = o; }
    for (int i = tid; i < 16 * 64; i += 512) { const int rl = i >> 6, ch = i & 63; const int c = 16 * q8 + rl, n = c & 63, s = ch >> 1, pp0 = (ch & 1) * 8; float v[8];
        const f32x2 w = pw[(31 - s) * 64 + n];
#pragma unroll
        for (int e = 0; e < 8; ++e) { const f32x2 b = Bb[n * 16 + pp0 + e]; v[e] = (c < 64) ? (w.x * b.x - w.y * b.y) : (w.x * b.y + w.y * b.x); }
        u32x4 o; o.x = pk2(v[0], v[1]); o.y = pk2(v[2], v[3]); o.z = pk2(v[4], v[5]); o.w = pk2(v[6], v[7]);
        *(u32x4*)(Eg + (size_t)c * 512 + s * 16 + pp0) = o; }
    __syncthreads();
}

__global__ void __launch_bounds__(NWAVES * 64, 2) skel_fwd(Args a) {
    extern __shared__ __attribute__((aligned(16))) unsigned char lds_raw[];
    LAS unsigned char* lds = (LAS unsigned char*)lds_raw;
    const int tid = threadIdx.x, lane = tid & 63, wave = __builtin_amdgcn_readfirstlane(tid >> 6);
    const int G = gridDim.x, bx = blockIdx.x;
    unsigned char* ws = a.ws;
    float* SSQ = (float*)(ws + WS_SSQ);
    float* KM = (float*)(ws + WS_KM);
    bf16_t* XB = (bf16_t*)(ws + WS_XB); bf16_t* PROJ = (bf16_t*)(ws + WS_PROJ); bf16_t* US5 = (bf16_t*)(ws + WS_US5);
    bf16_t* MIX = (bf16_t*)(ws + WS_MIX); bf16_t* HB = (bf16_t*)(ws + WS_H); float* XE = (float*)(ws + WS_XE); bf16_t* YG = (bf16_t*)(ws + WS_YG);
    const int lo = a.ph_lo, hi = a.ph_hi;
    volatile LAS unsigned* xst = (volatile LAS unsigned*)(lds + LDS_BYTES - 64);
    if (tid < 2) xst[tid] = 0u;
    __syncthreads();
    XcdBarrier xbar = xcd_barrier_post((unsigned*)(ws + WS_CTL), xst);
#define IN(k) (lo <= (k) && (k) < hi)
#ifndef PROBE_REP
#define PROBE_REP 0u
#endif
#define NREP(k) (((PROBE_REP >> (k)) & 1u) ? 2 : 1)
#define SEAM(k) do { if ((k) + 1 < hi || rep + 1 < NREP(k)) xcd_barrier(xbar); } while (0)
    unsigned* gctr = (unsigned*)(ws + WS_CTL) + 8192 + (bx & 7) * 16;
#define GSEAM(k, s) do { if ((k) + 1 < hi || rep + 1 < NREP(k)) { if (famok && NREP(k) == 1) fam_barrier(gctr + (s) * 1024, 32u); else xcd_barrier(xbar); } } while (0)
#define GSEAMP(k, s, PRE) do { if ((k) + 1 < hi || rep + 1 < NREP(k)) { if (famok && NREP(k) == 1) fam_barrier(gctr + (s) * 1024, 32u, (unsigned*)nullptr, PRE); else { PRE(); xcd_barrier(xbar); } } } while (0)
    static_assert((PROBE_REP & ((1u << 3) | (1u << 4) | (1u << 5) | (1u << 6) | (1u << 10) | (1u << 11) | (1u << 12) | (1u << 13))) == 0u, "phases around prefetching seams run once");
    auto pre4 = [&]() { pg8::Gemm g{XB, (const bf16_t*)(ws + WS_WGU0), 1024, 1024, 1024, 0, 0}; pg8::StaticOrder S; S.init(MTOK, 2 * FFN, G, bx); pg8::EpiSwiglu E{HB, SSQ + 1 * MTOK}; pg8::gemm_phase<1>(lds, g, S, E); };
    auto pre5 = [&]() { pg8::Gemm g{HB, (const bf16_t*)(ws + WS_WD0), FFN, FFN, FFN, 0, 0}; pg8::StaticOrder S; S.init(MTOK, 1024, G, bx); pg8::EpiResid E{XB, SSQ + 2 * MTOK}; pg8::gemm_phase<1>(lds, g, S, E); };
    auto pre6 = [&]() { pg8::Gemm g{XB, (const bf16_t*)(ws + WS_WIN1), 1024, 1024, 1024, 0, 0}; pg8::StaticOrder S; S.init(MTOK, 2048, G, bx); pg8::EpiProj1 E{US5, PROJ, SSQ + 2 * MTOK, KM, (float*)(ws + WS_KN2)}; pg8::gemm_phase<1>(lds, g, S, E); };
    auto pre11 = [&]() { pg8::Gemm g{MIX, (const bf16_t*)(ws + WS_WOUT1), 1024, 1024, 1024, 0, 0}; pg8::StaticOrder S; S.init(MTOK, 1024, G, bx); pg8::EpiResid E{XB, SSQ + 3 * MTOK}; pg8::gemm_phase<1>(lds, g, S, E); };
    auto pre12 = [&]() { pg8::Gemm g{XB, (const bf16_t*)(ws + WS_WGU1), 1024, 1024, 1024, 0, 0}; pg8::StaticOrder S; S.init(MTOK, 2 * FFN, G, bx); pg8::EpiSwiglu E{HB, SSQ + 3 * MTOK}; pg8::gemm_phase<1>(lds, g, S, E); };
    auto pre13 = [&]() { pg8::Gemm g{HB, (const bf16_t*)(ws + WS_WD1), FFN, FFN, FFN, 0, 0}; pg8::StaticOrder S; S.init(MTOK, 1024, G, bx); pg8::EpiFinal E{XB, SSQ + 4 * MTOK, (unsigned*)(ws + WS_CTL) + 4096, a.in[28], a.out, false}; pg8::gemm_phase<1>(lds, g, S, E); };

    bool famok = false;
    unsigned* fmask = (unsigned*)(ws + WS_CTL) + 8192 + 5 * 1024;
    if (IN(0) && tid == 0) (void)__hip_atomic_fetch_or(fmask + (bx & 7) * 16, 1u << xb_xcc_id(), __ATOMIC_RELAXED, __HIP_MEMORY_SCOPE_AGENT);
    if (IN(0)) _Pragma("clang loop unroll(disable)") for (int rep = 0; rep < NREP(0); ++rep) {
        LAS float* scr = (LAS float*)(lds + wave * 16384);
        const int gw = bx * NWAVES + wave, NGW = G * NWAVES;
        { const int items0 = 16 * 80;
          for (int it = gw; it < items0; it += NGW) p0_transpose_item(a.in[2], 1024, 2560, (bf16_t*)(ws + WS_WIN0), a.in[1], 0, scr, it, lane); }
        { const float* x = a.in[0];
          for (int r = gw; r < MTOK; r += 2 * NGW) { const int r2 = r + NGW;
              const f32x4* xr = (const f32x4*)(x + (size_t)r * D_MODEL) + lane; const f32x4* xr2 = (const f32x4*)(x + (size_t)r2 * D_MODEL) + lane; f32x4 v[4], w[4]; float s = 0.f, s2 = 0.f;
#pragma unroll
              for (int j = 0; j < 4; ++j) { v[j] = __builtin_nontemporal_load(xr + 64 * j); w[j] = __builtin_nontemporal_load(xr2 + 64 * j); }
#pragma unroll
              for (int j = 0; j < 4; ++j) { s += (v[j][0] * v[j][0] + v[j][1] * v[j][1]) + (v[j][2] * v[j][2] + v[j][3] * v[j][3]); s2 += (w[j][0] * w[j][0] + w[j][1] * w[j][1]) + (w[j][2] * w[j][2] + w[j][3] * w[j][3]); }
              s = wave_sum(s); s2 = wave_sum(s2); if (lane == 0) { SSQ[r] = s; SSQ[r2] = s2; }
              unsigned long long* o8 = (unsigned long long*)(XB + (size_t)r * D_MODEL) + lane; unsigned long long* o82 = (unsigned long long*)(XB + (size_t)r2 * D_MODEL) + lane;
#pragma unroll
              for (int j = 0; j < 4; ++j) { o8[64 * j] = (unsigned long long)pk2(v[j][0], v[j][1]) | ((unsigned long long)pk2(v[j][2], v[j][3]) << 32);
                  o82[64 * j] = (unsigned long long)pk2(w[j][0], w[j][1]) | ((unsigned long long)pk2(w[j][2], w[j][3]) << 32); } } }
        for (int it = bx; it < 256; it += G) p0_s5_ops(a, lds, it >> 3, it & 7);
        SEAM(0);
        if (rep + 1 == NREP(0) && 1 < hi) { bool ok = (G == 256);
#pragma unroll
            for (int j = 0; j < 8; ++j) { const unsigned m = xb_ld(fmask + j * 16); ok = ok && (__builtin_popcount(m) == 1); }
            famok = (bool)__builtin_amdgcn_readfirstlane((int)ok); }
    }
    if (IN(1)) _Pragma("clang loop unroll(disable)") for (int rep = 0; rep < NREP(1); ++rep) {
        pg8::Gemm g{XB, (const bf16_t*)(ws + WS_WIN0), 1024, 1024, 1024, 0, 0}; pg8::StaticOrder S; S.init(MTOK, 2560, G, bx);
        pg8::EpiProj0 E{PROJ, 2560, SSQ};
        pg8::gemm_phase(lds, g, S, E);
        if ((1) + 1 < hi || rep + 1 < NREP(1)) { if (famok && NREP(1) == 1 && NREP(2) == 1) fam_barrier((unsigned*)(ws + WS_CTL) + 8192 + 7 * 1024 + 512 + (bx & 7) * 16, 32u); else xcd_barrier(xbar); }
    }
    if (IN(2)) _Pragma("clang loop unroll(disable)") for (int rep = 0; rep < NREP(2); ++rep) {
        const int fam = bx & 7;
        if (G == 256) { if (bx < 128) { const int j = bx >> 3; rgp::rg_unit(a, PROJ, MIX, fam, j >> 1, j & 1, lds); } }
        else for (int u = bx; u < BATCH * 8 * 2; u += G) rgp::rg_unit(a, PROJ, MIX, u >> 4, (u >> 1) & 7, u & 1, lds);
        unsigned* qw = (unsigned*)(ws + WS_CTL) + 64 + 32 * rep + (G == 256 ? fam : 0);
        LAS unsigned char* vl = lds + wave * 16384;
        { unsigned u = 0; if (lane == 0) u = atomicAdd(qw, 1u); u = (unsigned)__builtin_amdgcn_readfirstlane((int)u);
          const unsigned ulim = (unsigned)(G == 256 ? 8 * 128 : BATCH * 8 * 128);
          while (u < ulim) {
              const int bh = (G == 256 ? fam * 8 : 0) + (int)(u >> 7), qt = 127 - (int)(u & 127);
              u = sbp::sb_unit(PROJ, MIX, bh >> 3, bh & 7, qt, vl, lane, qw); } }
        {
            asm volatile("s_waitcnt vmcnt(0) lgkmcnt(0)" ::: "memory");
            LAS float* scr = (LAS float*)vl;
            unsigned* cw = (unsigned*)(ws + WS_CTL) + 80 + rep;
            const TrJob jobs[10] = {
                {a.in[10], 1024, 1024, (bf16_t*)(ws + WS_WOUT0), nullptr, 0, 16 * 32},
                {a.in[25], 1024, FFN, (bf16_t*)(ws + WS_WGU0), a.in[24], 1, 16 * 88},
                {a.in[26], 1024, FFN, (bf16_t*)(ws + WS_WGU0), a.in[24], 2, 16 * 88},
                {a.in[27], FFN, 1024, (bf16_t*)(ws + WS_WD0), nullptr, 0, 44 * 32},
                {a.in[12], 1024, 2048, (bf16_t*)(ws + WS_WIN1), a.in[11], 0, 16 * 64},
                {a.in[23], 1024, 1024, (bf16_t*)(ws + WS_WOUT1), nullptr, 0, 16 * 32},
                {a.in[25] + (size_t)1024 * FFN, 1024, FFN, (bf16_t*)(ws + WS_WGU1), a.in[24] + 1024, 1, 16 * 88},
                {a.in[26] + (size_t)1024 * FFN, 1024, FFN, (bf16_t*)(ws + WS_WGU1), a.in[24] + 1024, 2, 16 * 88},
                {a.in[27] + (size_t)FFN * 1024, FFN, 1024, (bf16_t*)(ws + WS_WD1), nullptr, 0, 44 * 32},
                {a.in[21], 512, 512, (bf16_t*)(ws + WS_GLU), nullptr, 0, 8 * 16}};
            constexpr int CHUNK = 8, NITEMS = 512 + 1408 * 3 + 1024 + 512 + 1408 * 3 + 128;
            for (;;) {
                unsigned c0 = 0; if (lane == 0) c0 = atomicAdd(cw, 1u); c0 = (unsigned)__builtin_amdgcn_readfirstlane((int)c0);
                if (c0 * CHUNK >= (unsigned)NITEMS) break;
#pragma unroll 1
                for (int q = 0; q < CHUNK; ++q) { int it = (int)c0 * CHUNK + q; if (it >= NITEMS) break;
                    int base = 0;
#pragma unroll
                    for (int j = 0; j < 10; ++j) { const TrJob jb = jobs[j]; if (it >= base && it < base + jb.items) p0_transpose_item(jb.W, jb.K, jb.N, jb.WT, jb.sc, jb.mode, scr, it - base, lane); base += jb.items; } }
            }
        }
        SEAM(2);
    }
    if (IN(3)) _Pragma("clang loop unroll(disable)") for (int rep = 0; rep < NREP(3); ++rep) {
        pg8::Gemm g{MIX, (const bf16_t*)(ws + WS_WOUT0), 1024, 1024, 1024, 0, 0}; pg8::StaticOrder S; S.init(MTOK, 1024, G, bx);
        pg8::EpiResid E{XB, SSQ + 1 * MTOK};
        pg8::gemm_phase(lds, g, S, E); GSEAMP(3, 0, pre4);
    }
    if (IN(4)) _Pragma("clang loop unroll(disable)") for (int rep = 0; rep < NREP(4); ++rep) {
        pg8::Gemm g{XB, (const bf16_t*)(ws + WS_WGU0), 1024, 1024, 1024, 0, 0}; pg8::StaticOrder S; S.init(MTOK, 2 * FFN, G, bx);
        pg8::EpiSwiglu E{HB, SSQ + 1 * MTOK};
        if (lo == 4) pg8::gemm_phase<1>(lds, g, S, E);
        pg8::gemm_phase<2>(lds, g, S, E); GSEAMP(4, 1, pre5);
    }
    if (IN(5)) _Pragma("clang loop unroll(disable)") for (int rep = 0; rep < NREP(5); ++rep) {
        pg8::Gemm g{HB, (const bf16_t*)(ws + WS_WD0), FFN, FFN, FFN, 0, 0}; pg8::StaticOrder S; S.init(MTOK, 1024, G, bx);
        pg8::EpiResid E{XB, SSQ + 2 * MTOK};
        if (lo == 5) pg8::gemm_phase<1>(lds, g, S, E);
        pg8::gemm_phase<2>(lds, g, S, E);
        if ((5) + 1 < hi || rep + 1 < NREP(5)) { if (famok && NREP(5) == 1) fam_barrier(gctr + 6 * 1024, 32u, (unsigned*)(ws + WS_CTL) + 8192 + 7 * 1024, pre6); else { pre6(); xcd_barrier(xbar); } }
    }
    if (IN(6)) _Pragma("clang loop unroll(disable)") for (int rep = 0; rep < NREP(6); ++rep) {
        pg8::Gemm g{XB, (const bf16_t*)(ws + WS_WIN1), 1024, 1024, 1024, 0, 0}; pg8::StaticOrder S; S.init(MTOK, 2048, G, bx);
        pg8::EpiProj1 E{US5, PROJ, SSQ + 2 * MTOK, KM, (float*)(ws + WS_KN2)};
        if (lo == 6) pg8::gemm_phase<1>(lds, g, S, E);
        pg8::gemm_phase<2>(lds, g, S, E); SEAM(6);
    }
    if (IN(7)) _Pragma("clang loop unroll(disable)") for (int rep = 0; rep < NREP(7); ++rep) {
        constexpr int NS5 = 64;
        unsigned* ctl = (unsigned*)(ws + WS_CTL);
        if (bx < NS5 && G > NS5) {
            { pg8::Gemm g{US5, (const bf16_t*)(ws + WS_E), US5_LD, 512, 512, 640, 256 * 512}; pg8::GroupOrder S; S.init(4, 1, 32, NS5, bx);
              pg8::EpiXE E{XE};
              pg8::gemm_phase(lds, g, S, E); }
            if (famok && NREP(7) == 1) sub_barrier_sh(ctl + 104 + (bx & 7), NS5 / 8, ctl + 32, 8u); else sub_barrier(ctl + 32 + 3 * rep, NS5);
            { const float* A32 = (const float*)(ws + WS_A32);
              for (int i = bx * 512 + tid; i < BATCH * 32 * 64; i += NS5 * 512) { const int n = i & 63, g = (i >> 6) & 31, b = i >> 11;
                  const float ar = A32[(g * 64 + n) * 2], ai = A32[(g * 64 + n) * 2 + 1]; float xr = 0.f, xi = 0.f;
                  const float* e0 = XE + ((size_t)b * 128 * 32 + g) * 128 + n;
                  bf16_t* d0 = US5 + ((size_t)b * 128 * 32 + g) * 640 + 512 + n;
                  float cr[16], ci[16], nr[16], ni[16];
#pragma unroll
                  for (int s = 0; s < 16; ++s) { cr[s] = e0[(size_t)s * 4096]; ci[s] = e0[(size_t)s * 4096 + 64]; }
#pragma unroll 1
                  for (int jb = 0; jb < 8; ++jb) {
                      if (jb + 1 < 8) {
#pragma unroll
                          for (int s = 0; s < 16; ++s) { nr[s] = e0[(size_t)((jb + 1) * 16 + s) * 4096]; ni[s] = e0[(size_t)((jb + 1) * 16 + s) * 4096 + 64]; } }
#pragma unroll
                      for (int s = 0; s < 16; ++s) { bf16_t* dst = d0 + (size_t)(jb * 16 + s) * 20480; dst[0] = (bf16_t)f2bf(xr); dst[64] = (bf16_t)f2bf(xi);
                          const float t = ar * xr - ai * xi + cr[s]; xi = ar * xi + ai * xr + ci[s]; xr = t; }
#pragma unroll
                      for (int s = 0; s < 16; ++s) { cr[s] = nr[s]; ci[s] = ni[s]; } } } }
            if (famok && NREP(7) == 1) sub_barrier_sh(ctl + 112 + (bx & 7), NS5 / 8, ctl + 33, 8u); else sub_barrier(ctl + 33 + 3 * rep, NS5);
            { pg8::Gemm g{US5, (const bf16_t*)(ws + WS_TC), US5_LD, 640, 640, 640, 512 * 640}; pg8::GroupOrder S; S.init(4, 2, 32, NS5, bx);
              pg8::EpiS5Y E{US5, a.in[20], YG};
              pg8::gemm_phase(lds, g, S, E); }
        }
        {
            unsigned* qw = ctl + 48 + rep;
            volatile LAS unsigned* uq = (volatile LAS unsigned*)(lds + LDS_BYTES - 32);
            __syncthreads();
            if (tid == 0) uq[0] = atomicAdd(qw, 1u);
            for (;;) {
                __syncthreads();
                const unsigned u = (unsigned)__builtin_amdgcn_readfirstlane((int)uq[0]);
                __syncthreads();
                if (u >= (unsigned)(BATCH * 4 * 16)) break;
                int qb, hh; const int bb = u & 7;
                if (u < 256u) { qb = 15 - (int)(u >> 4); hh = 2 + (int)((u >> 3) & 1u); } else if (u < 384u) { qb = 15 - (int)((u - 256u) >> 3); hh = 1; } else { qb = 15 - (int)((u - 384u) >> 3); hh = 0; }
                mbp::moba_unit(PROJ, KM, (const float*)(ws + WS_KN2), MIX, bb, hh, qb, (char*)lds_raw, lds, qw, uq);
            }
        }
        SEAM(7);
    }
    if (IN(10)) _Pragma("clang loop unroll(disable)") for (int rep = 0; rep < NREP(10); ++rep) {
        pg8::Gemm g{YG, (const bf16_t*)(ws + WS_GLU), 512, 512, 512, 0, 0}; pg8::StaticOrder S; S.init(MTOK, 512, G, bx);
        pg8::EpiGlu E{YG, a.in[22], MIX};
        pg8::gemm_phase(lds, g, S, E); GSEAMP(10, 2, pre11);
    }
    if (IN(11)) _Pragma("clang loop unroll(disable)") for (int rep = 0; rep < NREP(11); ++rep) {
        pg8::Gemm g{MIX, (const bf16_t*)(ws + WS_WOUT1), 1024, 1024, 1024, 0, 0}; pg8::StaticOrder S; S.init(MTOK, 1024, G, bx);
        pg8::EpiResid E{XB, SSQ + 3 * MTOK};
        if (lo == 11) pg8::gemm_phase<1>(lds, g, S, E);
        pg8::gemm_phase<2>(lds, g, S, E); GSEAMP(11, 3, pre12);
    }
    if (IN(12)) _Pragma("clang loop unroll(disable)") for (int rep = 0; rep < NREP(12); ++rep) {
        pg8::Gemm g{XB, (const bf16_t*)(ws + WS_WGU1), 1024, 1024, 1024, 0, 0}; pg8::StaticOrder S; S.init(MTOK, 2 * FFN, G, bx);
        pg8::EpiSwiglu E{HB, SSQ + 3 * MTOK};
        if (lo == 12) pg8::gemm_phase<1>(lds, g, S, E);
        pg8::gemm_phase<2>(lds, g, S, E); GSEAMP(12, 4, pre13);
    }
    if (IN(13)) _Pragma("clang loop unroll(disable)") for (int rep = 0; rep < NREP(13); ++rep) {
        pg8::Gemm g{HB, (const bf16_t*)(ws + WS_WD1), FFN, FFN, FFN, 0, 0}; pg8::StaticOrder S; S.init(MTOK, 1024, G, bx);
        pg8::EpiFinal E{XB, SSQ + 4 * MTOK, (unsigned*)(ws + WS_CTL) + 4096, a.in[28], a.out, famok};
        if (lo == 13) pg8::gemm_phase<1>(lds, g, S, E);
        pg8::gemm_phase<2>(lds, g, S, E);
    }
#undef IN
#undef SEAM
#undef GSEAM
#undef GSEAMP
}

extern "C" void kernel_launch(void* const* d_in, const int* in_sizes, int n_in, void* d_out, int out_size, void* d_ws, size_t ws_size, hipStream_t stream) {
    static int grid = 0;
    if (grid == 0) {
        if (n_in != 29 || ws_size < WS_END) { fprintf(stderr, "kernel_launch: bad shapes / workspace (n_in %d, ws %zu, need %zu)\n", n_in, ws_size, (size_t)WS_END); grid = -1; return; }
        int dev = 0, cus = 0;
        (void)hipGetDevice(&dev); (void)hipDeviceGetAttribute(&cus, hipDeviceAttributeMultiprocessorCount, dev);
        if (hipFuncSetAttribute((const void*)skel_fwd, hipFuncAttributeMaxDynamicSharedMemorySize, LDS_BYTES) != hipSuccess) { fprintf(stderr, "hipFuncSetAttribute failed\n"); grid = -1; return; }
        int per_cu = 0;
        if (hipOccupancyMaxActiveBlocksPerMultiprocessor(&per_cu, (const void*)skel_fwd, NWAVES * 64, LDS_BYTES) != hipSuccess || per_cu < 1) { fprintf(stderr, "occupancy query failed (%d)\n", per_cu); per_cu = 1; }
        grid = (cus > 0 ? cus : 256) * (per_cu < 1 ? per_cu : 1);
    }
    if (grid < 0) return;
    (void)hipMemsetAsync((char*)d_ws + WS_CTL, 0, CTL_ZERO_BYTES, stream);
    Args a{};
    for (int i = 0; i < 29; ++i) a.in[i] = (const float*)d_in[i];
    a.out = (float*)d_out; a.ws = (unsigned char*)d_ws;
    a.ph_lo = 0; a.ph_hi = NPHASE;
    void* kargs[] = {&a};
    const hipError_t le = hipLaunchCooperativeKernel((const void*)skel_fwd, dim3(grid), dim3(NWAVES * 64), kargs, LDS_BYTES, stream);
    if (le != hipSuccess) fprintf(stderr, "kernel_launch: cooperative launch failed: %s (grid %d)\n", hipGetErrorString(le), grid);
}
```

```cpp
#include <hip/hip_runtime.h>
#include <cstdint>
#include <cstdio>

constexpr int D_MODEL = 1024, BATCH = 8, SEQ = 4096, MTOK = BATCH * SEQ;
constexpr int FFN = 2816;
constexpr float EPS = 1e-6f;

typedef unsigned short bf16_t;
#define LAS __attribute__((address_space(3)))
typedef short bf16x8 __attribute__((ext_vector_type(8)));
typedef float f32x4 __attribute__((ext_vector_type(4)));
typedef unsigned u32x4 __attribute__((ext_vector_type(4)));

__device__ __forceinline__ float bf2f(bf16_t v) { return __uint_as_float(((unsigned)v) << 16); }
__device__ __forceinline__ unsigned f2bf(float f) { unsigned u = __float_as_uint(f); return (u + 0x7fffu + ((u >> 16) & 1u)) >> 16; }
__device__ __forceinline__ unsigned pk2(float lo, float hi) { return f2bf(lo) | (f2bf(hi) << 16); }
__device__ __forceinline__ unsigned cvt_pk_bf16(float lo, float hi) { unsigned r; asm volatile("v_cvt_pk_bf16_f32 %0, %1, %2" : "=v"(r) : "v"(lo), "v"(hi)); return r; }
template <typename T> __device__ __forceinline__ float ldv(const T* p);
template <> __device__ __forceinline__ float ldv<float>(const float* p) { return *p; }
template <> __device__ __forceinline__ float ldv<bf16_t>(const bf16_t* p) { return bf2f(*p); }
template <typename T> __device__ __forceinline__ void stv(T* p, float v);
template <> __device__ __forceinline__ void stv<float>(float* p, float v) { *p = v; }
template <> __device__ __forceinline__ void stv<bf16_t>(bf16_t* p, float v) { *p = (bf16_t)f2bf(v); }

__device__ __forceinline__ float wave_sum(float v) {
#pragma unroll
    for (int o = 1; o < 64; o <<= 1) v += __shfl_xor(v, o);
    return v;
}
__device__ __forceinline__ float fast_sigmoid(float x) { return __builtin_amdgcn_rcpf(1.f + __builtin_amdgcn_exp2f(-1.4426950408889634f * x)); }
__device__ __forceinline__ float gelu_tanh_fast(float x) { const float u = 0.7978845608028654f * (x + 0.044715f * x * x * x); return x * fast_sigmoid(2.f * u); }
__device__ __forceinline__ float gelu_tanh(float x) { const float u = 0.7978845608028654f * (x + 0.044715f * x * x * x); return 0.5f * x * (1.f + tanhf(u)); }
__device__ __forceinline__ float sigmoidf_(float x) { return 1.f / (1.f + expf(-x)); }
__device__ __forceinline__ float logsig(float x) { return fminf(x, 0.f) - log1pf(expf(-fabsf(x))); }

constexpr size_t MiB = 1u << 20;
constexpr size_t WS_CTL = 0, CTL_ZERO_BYTES = 2 * MiB;
constexpr size_t WS_SSQ = 64 * 1024;
constexpr size_t WS_KM = 768 * 1024;
constexpr size_t WS_KN2 = 1024 * 1024;
constexpr size_t WS_A32 = 1024 * 1024 + 512 * 1024;
constexpr size_t WS_WIN0 = 2 * MiB, WS_WOUT0 = 7 * MiB, WS_WGU0 = 9 * MiB, WS_WD0 = 20 * MiB, WS_WIN1 = 26 * MiB, WS_WOUT1 = 30 * MiB;
constexpr size_t WS_WGU1 = 32 * MiB, WS_WD1 = 43 * MiB, WS_GLU = 49 * MiB, WS_E = 50 * MiB, WS_TC = 58 * MiB;
constexpr size_t WS_XB = 80 * MiB;
constexpr size_t WS_MIX = 144 * MiB;
constexpr size_t WS_YG = 208 * MiB;
constexpr size_t WS_PROJ = 240 * MiB;
constexpr size_t WS_US5 = 336 * MiB;
constexpr size_t WS_XE = 376 * MiB;
constexpr size_t WS_H = 240 * MiB;
constexpr size_t WS_END = 416 * MiB;
constexpr int US5_LD = 32 * 640;

namespace pg8 {
constexpr int BM = 256, BK = 64, HALF = 128, HTB = HALF * BK * 2, STAGE_BYTES = 8 * HTB, NXCD = 8, WGM = 8;
__host__ __device__ __forceinline__ int lds_byte(int r, int c) { const int st = (r >> 4) * 2 + (c >> 5), rr = r & 15, cc = c & 31, ob = rr * 64 + cc * 2; return st * 1024 + (ob ^ (((ob >> 9) & 1) << 5)); }
__host__ __device__ __forceinline__ void stage_rc(int b, int& R, int& C) { const int st = b / 1024, sb = b % 1024, swz = sb ^ (((sb >> 9) & 1) << 5); R = (st >> 1) * 16 + swz / 64; C = (st & 1) * 32 + (swz % 64) / 2; }
__host__ __device__ __forceinline__ int perm32(int rho) { const int n = rho >> 4, i = rho & 15; return 8 * (i >> 2) + 4 * n + (i & 3); }

struct Unit { int pm, pn, g; };
struct Gemm { const bf16_t* A; const bf16_t* Bt; int lda, ldb, K; long a_g, b_g; };

struct StaticOrder {
    int nM, nN, nwg, G, c;
    __device__ void init(int M, int N, int G_, int c_) { nM = M / BM; nN = N / BM; nwg = nM * nN; G = G_; c = c_; }
    __device__ bool next(int i, Unit& u) const {
        const long L = (long)i * G + c; if (L >= nwg) return false;
        int wgid = (int)L; { const int q = nwg / NXCD, r = nwg % NXCD, xcd = wgid % NXCD, off = wgid / NXCD; wgid = (xcd < r ? xcd * (q + 1) : r * (q + 1) + (xcd - r) * q) + off; }
        const int nig = WGM * nN, gid = wgid / nig, fm = gid * WGM, gsz = (nM - fm) < WGM ? (nM - fm) : WGM;
        u.pm = fm + ((wgid % nig) % gsz); u.pn = (wgid % nig) / gsz; u.g = 0; return true;
    }
};
struct GroupOrder {
    int nM, nN, ng, G, c;
    __device__ void init(int nM_, int nN_, int ng_, int G_, int c_) { nM = nM_; nN = nN_; ng = ng_; G = G_; c = c_; }
    __device__ bool next(int i, Unit& u) const {
        const int L = i * G + c; if (L >= nM * nN * ng) return false;
        u.g = L / (nM * nN); const int r = L % (nM * nN); u.pn = r / nM; u.pm = r % nM; return true;
    }
};

template <int MODE = 0, class Epi, class Sched, bool ALIGN_EPI = true, bool SP2 = true>
__device__ __forceinline__ void gemm_phase(LAS unsigned char* lds, const Gemm g, const Sched& S, const Epi& E) {
    const int tid = threadIdx.x, wid = __builtin_amdgcn_readfirstlane(tid >> 6), lane = tid & 63, wr = wid >> 2, wc = wid & 3, fr = lane & 15, fq = lane >> 4;
    const int K = g.K, nt = K / BK;
    unsigned voffA[2], voffB[2];
#pragma unroll
    for (int i = 0; i < 2; ++i) { int R, C; stage_rc(tid * 16 + i * 8192, R, C); const int Rb = Epi::PERM ? ((R & ~31) + perm32(R & 31)) : R;
        voffA[i] = (unsigned)(R * g.lda + C) * 2u; voffB[i] = (unsigned)(Rb * g.ldb + C) * 2u; }
    const size_t kstep = (size_t)(BK * 2);
    const size_t hstepA = (size_t)HALF * g.lda * 2, hstepB = (size_t)HALF * g.ldb * 2;
    const unsigned ldsw = (unsigned)wid * 1024u;
    const int aoff = lds_byte(wr * 64 + fr, fq * 8), boff = lds_byte(wc * 32 + fr, fq * 8);
#define PG8_SA(b, h) (((b) * 2 + (h)) * HTB)
#define PG8_SB(b, h) ((4 + (b) * 2 + (h)) * HTB)
#define PG8_STAGE(bufoff, gbase, voff) do { _Pragma("unroll") for (int _i = 0; _i < 2; ++_i) \
        __builtin_amdgcn_global_load_lds((const unsigned*)((const char*)(gbase) + (voff)[_i]), (LAS unsigned*)(lds + (bufoff) + ldsw + _i * 8192), 16, 0, 0); } while (0)
#define PG8_LDA(dst, b, h) do { _Pragma("unroll") for (int m = 0; m < 4; ++m) _Pragma("unroll") for (int k = 0; k < 2; ++k) dst[m][k] = *(const LAS bf16x8*)(lds + PG8_SA(b, h) + aoff + m * 2048 + k * 1024); } while (0)
#define PG8_LDB(dst, b, h) do { _Pragma("unroll") for (int n = 0; n < 2; ++n) _Pragma("unroll") for (int k = 0; k < 2; ++k) dst[n][k] = *(const LAS bf16x8*)(lds + PG8_SB(b, h) + boff + n * 2048 + k * 1024); } while (0)
#define PG8_MMA(ai, bj, At, Bt) do { __builtin_amdgcn_s_setprio(1); _Pragma("unroll") for (int m = 0; m < 4; ++m) _Pragma("unroll") for (int n = 0; n < 2; ++n) _Pragma("unroll") for (int k = 0; k < 2; ++k) \
        acc[ai][bj][m][n] = __builtin_amdgcn_mfma_f32_16x16x32_bf16(Bt[n][k], At[m][k], acc[ai][bj][m][n], 0, 0, 0); __builtin_amdgcn_s_setprio(0); } while (0)
#define PG8_WAIT_V(n) asm volatile("s_waitcnt vmcnt(" #n ")" ::: "memory")
#define PG8_WAIT_L(n) asm volatile("s_waitcnt lgkmcnt(" #n ")" ::: "memory")
#define PG8_BAR __builtin_amdgcn_s_barrier()
#define PG8_SCHED __builtin_amdgcn_sched_barrier(0)
#define PG8_ABASE(u) ((const char*)g.A + ((size_t)(u).g * g.a_g + (size_t)(u).pm * BM * g.lda) * 2)
#define PG8_BBASE(u) ((const char*)g.Bt + ((size_t)(u).g * g.b_g + (size_t)(u).pn * BM * g.ldb) * 2)
    Unit cur, nxt; int ui = 0;
    if (!S.next(0, cur)) return;
    if constexpr (MODE == 1) { const char* pB = PG8_BBASE(cur); PG8_STAGE(PG8_SB(0, 0), pB, voffB); PG8_STAGE(PG8_SB(0, 1), pB + hstepB, voffB); return; }
    f32x4 acc[2][2][4][2];
    E.init(acc, cur, wr, wc, fr, fq);
    bf16x8 At[4][2], B0[2][2], B1[2][2];
    const char* cA = PG8_ABASE(cur); const char* cB = PG8_BBASE(cur);
    static_assert(SP2, "only the SP2 loop is carried here");
    if constexpr (MODE != 2) { PG8_STAGE(PG8_SB(0, 0), cB, voffB); PG8_STAGE(PG8_SB(0, 1), cB + hstepB, voffB); }
    PG8_STAGE(PG8_SA(0, 0), cA, voffA); PG8_STAGE(PG8_SA(0, 1), cA + hstepA, voffA);
    if (wr == 1) PG8_BAR;
    PG8_WAIT_V(2); PG8_BAR;
    PG8_STAGE(PG8_SB(1, 0), cB + kstep, voffB); PG8_STAGE(PG8_SA(1, 0), cA + kstep, voffA); PG8_STAGE(PG8_SB(1, 1), cB + hstepB + kstep, voffB);
    PG8_WAIT_V(6); PG8_BAR;
    for (;;) {
        const bool has_next = S.next(ui + 1, nxt);
        const char* nA = has_next ? PG8_ABASE(nxt) : cA; const char* nB = has_next ? PG8_BBASE(nxt) : cB;
        for (int t = 0; t < nt; t += 2) {
            const bool last = (t == nt - 2);
            const char* a1 = cA + (size_t)(t + 1) * kstep;
            const char* a2 = last ? nA : cA + (size_t)(t + 2) * kstep; const char* b2 = last ? nB : cB + (size_t)(t + 2) * kstep;
            const char* a3 = a2 + kstep; const char* b3 = b2 + kstep;
            PG8_LDB(B0, 0, 0); PG8_LDB(B1, 0, 1); PG8_SCHED; PG8_LDA(At, 0, 0); PG8_STAGE(PG8_SA(1, 1), a1 + hstepA, voffA);
            PG8_WAIT_V(8); PG8_WAIT_L(0); PG8_BAR; PG8_MMA(0, 0, At, B0); PG8_MMA(0, 1, At, B1); PG8_BAR; PG8_SCHED;
            PG8_LDA(At, 0, 1); PG8_STAGE(PG8_SB(0, 0), b2, voffB); PG8_STAGE(PG8_SB(0, 1), b2 + hstepB, voffB); PG8_STAGE(PG8_SA(0, 0), a2, voffA);
            PG8_WAIT_V(8); PG8_WAIT_L(0); PG8_BAR; PG8_MMA(1, 0, At, B0); PG8_MMA(1, 1, At, B1); PG8_BAR; PG8_SCHED;
            PG8_LDB(B0, 1, 0); PG8_LDB(B1, 1, 1); PG8_SCHED; PG8_LDA(At, 1, 0); PG8_STAGE(PG8_SA(0, 1), a2 + hstepA, voffA);
            PG8_WAIT_V(8); PG8_WAIT_L(0); PG8_BAR; PG8_MMA(0, 0, At, B0); PG8_MMA(0, 1, At, B1); PG8_BAR; PG8_SCHED;
            PG8_LDA(At, 1, 1); PG8_STAGE(PG8_SB(1, 0), b3, voffB); PG8_STAGE(PG8_SB(1, 1), b3 + hstepB, voffB); PG8_STAGE(PG8_SA(1, 0), a3, voffA);
            PG8_WAIT_V(8); PG8_WAIT_L(0); PG8_BAR; PG8_MMA(1, 0, At, B0); PG8_MMA(1, 1, At, B1); PG8_BAR; PG8_SCHED;
        }
        if constexpr (ALIGN_EPI) { if (wr == 0) PG8_BAR; }
        E(acc, cur, wr, wc, fr, fq);
        if (!has_next) break;
        E.init(acc, nxt, wr, wc, fr, fq);
        cur = nxt; cA = nA; cB = nB; ++ui;
        if constexpr (ALIGN_EPI) { if (wr == 1) PG8_BAR; }
    }
    PG8_WAIT_V(0);
    if constexpr (!ALIGN_EPI) { if (wr == 0) PG8_BAR; }
    PG8_BAR;
#undef PG8_SA
#undef PG8_SB
#undef PG8_STAGE
#undef PG8_LDA
#undef PG8_LDB
#undef PG8_MMA
#undef PG8_WAIT_V
#undef PG8_WAIT_L
#undef PG8_BAR
#undef PG8_SCHED
#undef PG8_ABASE
#undef PG8_BBASE
}

typedef const f32x4 (&AccRef)[2][2][4][2];
__device__ __forceinline__ u32x4 pack8(f32x4 v0, f32x4 v1) { u32x4 w; w.x = cvt_pk_bf16(v0[0], v0[1]); w.y = cvt_pk_bf16(v0[2], v0[3]); w.z = cvt_pk_bf16(v1[0], v1[1]); w.w = cvt_pk_bf16(v1[2], v1[3]); return w; }
__device__ __forceinline__ float rstd_of(const float* ssq, int row) { return rsqrtf(ssq[row] * (1.f / D_MODEL) + EPS); }

struct EpiProj0 {
    static constexpr bool PERM = true;
    bf16_t* O; int ldc; const float* ssq;
    __device__ __forceinline__ void init(f32x4 (&acc)[2][2][4][2], const Unit&, int, int, int, int) const {
#pragma unroll
        for (int a = 0; a < 2; ++a)
#pragma unroll
            for (int b = 0; b < 2; ++b)
#pragma unroll
                for (int m = 0; m < 4; ++m)
#pragma unroll
                    for (int n = 0; n < 2; ++n) acc[a][b][m][n] = (f32x4){0.f, 0.f, 0.f, 0.f}; }
    __device__ __forceinline__ void operator()(AccRef acc, const Unit& u, int wr, int wc, int fr, int fq) const {
        const int row0 = u.pm * BM + wr * 64 + fr, col0 = u.pn * BM + wc * 32 + 8 * fq;
        float sv[2][4];
#pragma unroll
        for (int ai = 0; ai < 2; ++ai)
#pragma unroll
            for (int m = 0; m < 4; ++m) sv[ai][m] = ssq[row0 + ai * HALF + m * 16];
#pragma unroll
        for (int ai = 0; ai < 2; ++ai)
#pragma unroll
            for (int m = 0; m < 4; ++m) { const int row = row0 + ai * HALF + m * 16; const float rs = rsqrtf(sv[ai][m] * (1.f / D_MODEL) + EPS); bf16_t* rowp = O + (size_t)row * ldc + col0;
#pragma unroll
                for (int bj = 0; bj < 2; ++bj) *(u32x4*)(rowp + bj * HALF) = pack8(acc[ai][bj][m][0] * rs, acc[ai][bj][m][1] * rs); }
    }
};
struct EpiProj1 {
    static constexpr bool PERM = true;
    bf16_t* US5; bf16_t* QKV; const float* ssq; float* KM; float* KN2;
    __device__ __forceinline__ void init(f32x4 (&acc)[2][2][4][2], const Unit&, int, int, int, int) const {
#pragma unroll
        for (int a = 0; a < 2; ++a)
#pragma unroll
            for (int b = 0; b < 2; ++b)
#pragma unroll
                for (int m = 0; m < 4; ++m)
#pragma unroll
                    for (int n = 0; n < 2; ++n) acc[a][b][m][n] = (f32x4){0.f, 0.f, 0.f, 0.f}; }
    __device__ __forceinline__ void operator()(AccRef acc, const Unit& u, int wr, int wc, int fr, int fq) const {
        const int row0 = u.pm * BM + wr * 64 + fr, col0 = u.pn * BM + wc * 32 + 8 * fq;
        const bool isK = (u.pn == 4 || u.pn == 5);
        f32x4 cs[2][2];
#pragma unroll
        for (int bj = 0; bj < 2; ++bj) { cs[bj][0] = (f32x4){0.f, 0.f, 0.f, 0.f}; cs[bj][1] = (f32x4){0.f, 0.f, 0.f, 0.f}; }
        float sv[2][4];
#pragma unroll
        for (int ai = 0; ai < 2; ++ai)
#pragma unroll
            for (int m = 0; m < 4; ++m) sv[ai][m] = ssq[row0 + ai * HALF + m * 16];
#pragma unroll
        for (int ai = 0; ai < 2; ++ai)
#pragma unroll
            for (int m = 0; m < 4; ++m) { const int row = row0 + ai * HALF + m * 16; const float rs = rsqrtf(sv[ai][m] * (1.f / D_MODEL) + EPS);
#pragma unroll
                for (int bj = 0; bj < 2; ++bj) { const f32x4 v0 = acc[ai][bj][m][0] * rs, v1 = acc[ai][bj][m][1] * rs; const int col = col0 + bj * HALF;
                    bf16_t* dst;
                    if (u.pn < 2) dst = US5 + ((size_t)((row >> 5) * 32 + (col >> 4)) * 640 + (row & 31) * 16 + (col & 15));
                    else dst = QKV + (size_t)row * 1536 + (col - 512);
                    *(u32x4*)dst = pack8(v0, v1);
                    cs[bj][0] += v0; cs[bj][1] += v1;
                    if (isK) { float sq = (v0[0] * v0[0] + v0[1] * v0[1]) + (v0[2] * v0[2] + v0[3] * v0[3]) + (v1[0] * v1[0] + v1[1] * v1[1]) + (v1[2] * v1[2] + v1[3] * v1[3]);
                        sq += __shfl_xor(sq, 16); sq += __shfl_xor(sq, 32);
                        if (fq == 0) atomicAdd(KN2 + (size_t)row * 4 + ((col - 1024) >> 7), sq); } } }
        if (isK) {
#pragma unroll
            for (int bj = 0; bj < 2; ++bj)
#pragma unroll
                for (int n = 0; n < 2; ++n)
#pragma unroll
                    for (int e = 0; e < 4; ++e) { float s = cs[bj][n][e]; s += __shfl_xor(s, 1); s += __shfl_xor(s, 2); s += __shfl_xor(s, 4); s += __shfl_xor(s, 8);
                        if (fr == 0) { const int col = col0 + bj * HALF + 4 * n + e - 1024; const int h = col >> 7, d = col & 127, b = u.pm >> 4, blk = u.pm & 15;
                            atomicAdd(KM + ((size_t)((b * 4 + h) * 16 + blk) * 128 + d), s * (1.f / 256.f)); } }
        }
    }
};
struct EpiResid {
    static constexpr bool PERM = true;
    bf16_t* XB; float* ssq;
    __device__ __forceinline__ void init(f32x4 (&acc)[2][2][4][2], const Unit& u, int wr, int wc, int fr, int fq) const {
        const int row0 = u.pm * BM + wr * 64 + fr, col0 = u.pn * BM + wc * 32 + 8 * fq;
        u32x4 ow[2][4][2];
#pragma unroll
        for (int ai = 0; ai < 2; ++ai)
#pragma unroll
            for (int m = 0; m < 4; ++m)
#pragma unroll
                for (int bj = 0; bj < 2; ++bj) ow[ai][m][bj] = __builtin_nontemporal_load((const u32x4*)(XB + (size_t)(row0 + ai * HALF + m * 16) * D_MODEL + col0 + bj * HALF));
#pragma unroll
        for (int ai = 0; ai < 2; ++ai)
#pragma unroll
            for (int m = 0; m < 4; ++m)
#pragma unroll
                for (int bj = 0; bj < 2; ++bj) { const u32x4 w = ow[ai][m][bj];
                    acc[ai][bj][m][0] = (f32x4){__uint_as_float(w.x << 16), __uint_as_float(w.x & 0xffff0000u), __uint_as_float(w.y << 16), __uint_as_float(w.y & 0xffff0000u)};
                    acc[ai][bj][m][1] = (f32x4){__uint_as_float(w.z << 16), __uint_as_float(w.z & 0xffff0000u), __uint_as_float(w.w << 16), __uint_as_float(w.w & 0xffff0000u)}; } }
    __device__ __forceinline__ void operator()(AccRef acc, const Unit& u, int wr, int wc, int fr, int fq) const {
        const int row0 = u.pm * BM + wr * 64 + fr, col0 = u.pn * BM + wc * 32 + 8 * fq;
#pragma unroll
        for (int ai = 0; ai < 2; ++ai) {
#pragma unroll
            for (int m = 0; m < 4; ++m) { const int row = row0 + ai * HALF + m * 16; const size_t off = (size_t)row * D_MODEL + col0; float sq = 0.f;
#pragma unroll
                for (int bj = 0; bj < 2; ++bj) { const f32x4 v0 = acc[ai][bj][m][0], v1 = acc[ai][bj][m][1];
                    *(u32x4*)(XB + off + bj * HALF) = pack8(v0, v1);
                    sq += (v0[0] * v0[0] + v0[1] * v0[1]) + (v0[2] * v0[2] + v0[3] * v0[3]) + (v1[0] * v1[0] + v1[1] * v1[1]) + (v1[2] * v1[2] + v1[3] * v1[3]); }
                sq += __shfl_xor(sq, 16); sq += __shfl_xor(sq, 32);
                if (fq == 0) atomicAdd(ssq + row, sq); }
        }
    }
};
struct EpiFinal {
    static constexpr bool PERM = true;
    const bf16_t* XB; float* ssq; unsigned* cnt; const float* gfin; float* out;
    __device__ __forceinline__ void init(f32x4 (&acc)[2][2][4][2], const Unit& u, int wr, int wc, int fr, int fq) const {
        const int row0 = u.pm * BM + wr * 64 + fr, col0 = u.pn * BM + wc * 32 + 8 * fq;
        u32x4 ow[2][4][2];
#pragma unroll
        for (int ai = 0; ai < 2; ++ai)
#pragma unroll
            for (int m = 0; m < 4; ++m)
#pragma unroll
                for (int bj = 0; bj < 2; ++bj) ow[ai][m][bj] = __builtin_nontemporal_load((const u32x4*)(XB + (size_t)(row0 + ai * HALF + m * 16) * D_MODEL + col0 + bj * HALF));
#pragma unroll
        for (int ai = 0; ai < 2; ++ai)
#pragma unroll
            for (int m = 0; m < 4; ++m)
#pragma unroll
                for (int bj = 0; bj < 2; ++bj) { const u32x4 w = ow[ai][m][bj];
                    acc[ai][bj][m][0] = (f32x4){__uint_as_float(w.x << 16), __uint_as_float(w.x & 0xffff0000u), __uint_as_float(w.y << 16), __uint_as_float(w.y & 0xffff0000u)};
                    acc[ai][bj][m][1] = (f32x4){__uint_as_float(w.z << 16), __uint_as_float(w.z & 0xffff0000u), __uint_as_float(w.w << 16), __uint_as_float(w.w & 0xffff0000u)}; } }
    __device__ __forceinline__ void operator()(f32x4 (&acc)[2][2][4][2], const Unit& u, int wr, int wc, int fr, int fq) const {
        const int row0 = u.pm * BM + wr * 64 + fr, col0 = u.pn * BM + wc * 32 + 8 * fq;
#pragma unroll
        for (int ai = 0; ai < 2; ++ai) {
#pragma unroll
            for (int m = 0; m < 4; ++m) { const int row = row0 + ai * HALF + m * 16; float sq = 0.f;
#pragma unroll
                for (int bj = 0; bj < 2; ++bj) { const f32x4 v0 = acc[ai][bj][m][0], v1 = acc[ai][bj][m][1];
                    sq += (v0[0] * v0[0] + v0[1] * v0[1]) + (v0[2] * v0[2] + v0[3] * v0[3]) + (v1[0] * v1[0] + v1[1] * v1[1]) + (v1[2] * v1[2] + v1[3] * v1[3]); }
                sq += __shfl_xor(sq, 16); sq += __shfl_xor(sq, 32);
                if (fq == 0) atomicAdd(ssq + row, sq); }
        }
        asm volatile("s_waitcnt vmcnt(0) lgkmcnt(0)" ::: "memory"); __builtin_amdgcn_s_barrier(); asm volatile("" ::: "memory");
        if (threadIdx.x == 0) {
            unsigned* c = cnt + 64 * u.pm;
            __builtin_amdgcn_fence(__ATOMIC_RELEASE, "agent");
            asm volatile("s_waitcnt vmcnt(0)" ::: "memory");
            (void)__hip_atomic_fetch_add(c, 1u, __ATOMIC_RELAXED, __HIP_MEMORY_SCOPE_AGENT);
            unsigned sp = 0u;
            while (__hip_atomic_load(c, __ATOMIC_RELAXED, __HIP_MEMORY_SCOPE_AGENT) < 4u) { __builtin_amdgcn_s_sleep(1); if (++sp > (1u << 22)) break; }
            __builtin_amdgcn_fence(__ATOMIC_ACQUIRE, "agent");
            asm volatile("s_waitcnt vmcnt(0)" ::: "memory");
        }
        asm volatile("s_waitcnt vmcnt(0) lgkmcnt(0)" ::: "memory"); __builtin_amdgcn_s_barrier(); asm volatile("" ::: "memory");
        f32x4 gv[2][2];
#pragma unroll
        for (int bj = 0; bj < 2; ++bj) { gv[bj][0] = *(const f32x4*)(gfin + col0 + bj * HALF); gv[bj][1] = *(const f32x4*)(gfin + col0 + bj * HALF + 4); }
        float sv[2][4];
#pragma unroll
        for (int ai = 0; ai < 2; ++ai)
#pragma unroll
            for (int m = 0; m < 4; ++m) sv[ai][m] = __hip_atomic_load(ssq + row0 + ai * HALF + m * 16, __ATOMIC_RELAXED, __HIP_MEMORY_SCOPE_AGENT);
#pragma unroll
        for (int ai = 0; ai < 2; ++ai)
#pragma unroll
            for (int m = 0; m < 4; ++m) { const int row = row0 + ai * HALF + m * 16; const float rs = rsqrtf(sv[ai][m] * (1.f / D_MODEL) + EPS); float* op = out + (size_t)row * D_MODEL + col0;
#pragma unroll
                for (int bj = 0; bj < 2; ++bj) { __builtin_nontemporal_store(acc[ai][bj][m][0] * rs * gv[bj][0], (f32x4*)(op + bj * HALF)); __builtin_nontemporal_store(acc[ai][bj][m][1] * rs * gv[bj][1], (f32x4*)(op + bj * HALF + 4)); } }
    }
};
struct EpiSwiglu {
    static constexpr bool PERM = true;
    bf16_t* H; const float* ssq;
    __device__ __forceinline__ void init(f32x4 (&acc)[2][2][4][2], const Unit&, int, int, int, int) const {
#pragma unroll
        for (int a = 0; a < 2; ++a)
#pragma unroll
            for (int b = 0; b < 2; ++b)
#pragma unroll
                for (int m = 0; m < 4; ++m)
#pragma unroll
                    for (int n = 0; n < 2; ++n) acc[a][b][m][n] = (f32x4){0.f, 0.f, 0.f, 0.f}; }
    __device__ __forceinline__ void operator()(AccRef acc, const Unit& u, int wr, int wc, int fr, int fq) const {
        const int row0 = u.pm * BM + wr * 64 + fr, col0 = u.pn * HALF + wc * 32 + 8 * fq;
        float sv[2][4];
#pragma unroll
        for (int ai = 0; ai < 2; ++ai)
#pragma unroll
            for (int m = 0; m < 4; ++m) sv[ai][m] = ssq[row0 + ai * HALF + m * 16];
#pragma unroll
        for (int ai = 0; ai < 2; ++ai)
#pragma unroll
            for (int m = 0; m < 4; ++m) { const int row = row0 + ai * HALF + m * 16; const float rs = rsqrtf(sv[ai][m] * (1.f / D_MODEL) + EPS);
                f32x4 hv[2];
#pragma unroll
                for (int n = 0; n < 2; ++n) { const f32x4 g = acc[ai][0][m][n] * rs, uu = acc[ai][1][m][n] * rs;
#pragma unroll
                    for (int e = 0; e < 4; ++e) hv[n][e] = g[e] * fast_sigmoid(g[e]) * uu[e]; }
                *(u32x4*)(H + (size_t)row * FFN + col0) = pack8(hv[0], hv[1]); }
    }
};
struct EpiXE {
    static constexpr bool PERM = false;
    float* XE;
    __device__ __forceinline__ void init(f32x4 (&acc)[2][2][4][2], const Unit&, int, int, int, int) const {
#pragma unroll
        for (int a = 0; a < 2; ++a)
#pragma unroll
            for (int b = 0; b < 2; ++b)
#pragma unroll
                for (int m = 0; m < 4; ++m)
#pragma unroll
                    for (int n = 0; n < 2; ++n) acc[a][b][m][n] = (f32x4){0.f, 0.f, 0.f, 0.f}; }
    __device__ __forceinline__ void operator()(AccRef acc, const Unit& u, int wr, int wc, int fr, int fq) const {
        const int row0 = u.pm * BM + wr * 64 + fr, col0 = wc * 32 + 4 * fq;
#pragma unroll
        for (int ai = 0; ai < 2; ++ai)
#pragma unroll
            for (int m = 0; m < 4; ++m) { const int J = row0 + ai * HALF + m * 16; float* dst = XE + ((size_t)J * 32 + u.g) * 128 + col0;
#pragma unroll
                for (int n = 0; n < 2; ++n) *(f32x4*)(dst + 16 * n) = acc[ai][0][m][n]; }
    }
};
struct EpiS5Y {
    static constexpr bool PERM = true;
    const bf16_t* US5; const float* dskip; bf16_t* YG;
    __device__ __forceinline__ void init(f32x4 (&acc)[2][2][4][2], const Unit& u, int wr, int wc, int fr, int fq) const {
        const int row0 = u.pm * BM + wr * 64 + fr, col0 = u.pn * BM + wc * 32 + 8 * fq;
        u32x4 uv[2][4][2]; f32x4 dv[2][2];
#pragma unroll
        for (int bj = 0; bj < 2; ++bj) { const int p0 = (col0 + bj * HALF) & 15; dv[bj][0] = *(const f32x4*)(dskip + u.g * 16 + p0); dv[bj][1] = *(const f32x4*)(dskip + u.g * 16 + p0 + 4); }
#pragma unroll
        for (int ai = 0; ai < 2; ++ai)
#pragma unroll
            for (int m = 0; m < 4; ++m)
#pragma unroll
                for (int bj = 0; bj < 2; ++bj) { const int col = col0 + bj * HALF; uv[ai][m][bj] = *(const u32x4*)(US5 + ((size_t)(row0 + ai * HALF + m * 16) * 32 + u.g) * 640 + (col >> 4) * 16 + (col & 15)); }
#pragma unroll
        for (int ai = 0; ai < 2; ++ai)
#pragma unroll
            for (int m = 0; m < 4; ++m)
#pragma unroll
                for (int bj = 0; bj < 2; ++bj) { const u32x4 uw = uv[ai][m][bj]; const f32x4 d0 = dv[bj][0], d1 = dv[bj][1];
                    acc[ai][bj][m][0] = (f32x4){d0[0] * __uint_as_float(uw.x << 16), d0[1] * __uint_as_float(uw.x & 0xffff0000u), d0[2] * __uint_as_float(uw.y << 16), d0[3] * __uint_as_float(uw.y & 0xffff0000u)};
                    acc[ai][bj][m][1] = (f32x4){d1[0] * __uint_as_float(uw.z << 16), d1[1] * __uint_as_float(uw.z & 0xffff0000u), d1[2] * __uint_as_float(uw.w << 16), d1[3] * __uint_as_float(uw.w & 0xffff0000u)}; } }
    __device__ __forceinline__ void operator()(AccRef acc, const Unit& u, int wr, int wc, int fr, int fq) const {
        const int row0 = u.pm * BM + wr * 64 + fr, col0 = u.pn * BM + wc * 32 + 8 * fq;
#pragma unroll
        for (int ai = 0; ai < 2; ++ai)
#pragma unroll
            for (int m = 0; m < 4; ++m) { const int J = row0 + ai * HALF + m * 16;
#pragma unroll
                for (int bj = 0; bj < 2; ++bj) { const int col = col0 + bj * HALF, tau = col >> 4, p0 = col & 15;
                    f32x4 y0 = acc[ai][bj][m][0], y1 = acc[ai][bj][m][1];
#pragma unroll
                    for (int e = 0; e < 4; ++e) { y0[e] = gelu_tanh_fast(y0[e]); y1[e] = gelu_tanh_fast(y1[e]); }
                    *(u32x4*)(YG + ((size_t)J * 32 + tau) * 512 + u.g * 16 + p0) = pack8(y0, y1); } }
    }
};
struct EpiGlu {
    static constexpr bool PERM = true;
    const bf16_t* YG; const float* bias; bf16_t* MIX;
    __device__ __forceinline__ void init(f32x4 (&acc)[2][2][4][2], const Unit&, int, int, int, int) const {
#pragma unroll
        for (int a = 0; a < 2; ++a)
#pragma unroll
            for (int b = 0; b < 2; ++b)
#pragma unroll
                for (int m = 0; m < 4; ++m)
#pragma unroll
                    for (int n = 0; n < 2; ++n) acc[a][b][m][n] = (f32x4){0.f, 0.f, 0.f, 0.f}; }
    __device__ __forceinline__ void operator()(AccRef acc, const Unit& u, int wr, int wc, int fr, int fq) const {
        const int row0 = u.pm * BM + wr * 64 + fr, col0 = u.pn * BM + wc * 32 + 8 * fq;
#pragma unroll
        for (int ai = 0; ai < 2; ++ai) {
        u32x4 yv[4][2];
#pragma unroll
            for (int m = 0; m < 4; ++m)
#pragma unroll
                for (int bj = 0; bj < 2; ++bj) yv[m][bj] = *(const u32x4*)(YG + (size_t)(row0 + ai * HALF + m * 16) * 512 + col0 + bj * HALF);
#pragma unroll
            for (int m = 0; m < 4; ++m) { const int row = row0 + ai * HALF + m * 16;
#pragma unroll
                for (int bj = 0; bj < 2; ++bj) { const int col = col0 + bj * HALF;
                    const u32x4 yw = yv[m][bj];
                    const f32x4 b0 = *(const f32x4*)(bias + col), b1 = *(const f32x4*)(bias + col + 4);
                    const f32x4 a0 = acc[ai][bj][m][0] + b0, a1 = acc[ai][bj][m][1] + b1;
                    f32x4 o0, o1;
                    o0[0] = __uint_as_float(yw.x << 16) * fast_sigmoid(a0[0]); o0[1] = __uint_as_float(yw.x & 0xffff0000u) * fast_sigmoid(a0[1]);
                    o0[2] = __uint_as_float(yw.y << 16) * fast_sigmoid(a0[2]); o0[3] = __uint_as_float(yw.y & 0xffff0000u) * fast_sigmoid(a0[3]);
                    o1[0] = __uint_as_float(yw.z << 16) * fast_sigmoid(a1[0]); o1[1] = __uint_as_float(yw.z & 0xffff0000u) * fast_sigmoid(a1[1]);
                    o1[2] = __uint_as_float(yw.w << 16) * fast_sigmoid(a1[2]); o1[3] = __uint_as_float(yw.w & 0xffff0000u) * fast_sigmoid(a1[3]);
                    *(u32x4*)(MIX + (size_t)row * D_MODEL + col) = pack8(o0, o1); } }
        }
    }
};
}


namespace sbp {
typedef float f32x16 __attribute__((ext_vector_type(16)));
typedef short s16x4 __attribute__((ext_vector_type(4)));
typedef short v4i16_t __attribute__((ext_vector_type(4)));
__device__ __forceinline__ int crow(int r, int hi) { return (r & 3) + 8 * (r >> 2) + 4 * hi; }
__device__ __forceinline__ s16x4 vtr(LAS const unsigned char* p) { return __builtin_bit_cast(s16x4, __builtin_amdgcn_ds_read_tr16_b64_v4i16((LAS v4i16_t*)p)); }

template <bool DIAG>
__device__ __forceinline__ void sb_weights(const f32x16& p0, const f32x16& p1, int tl  , int hi, float& carry, bf16x8 (&pf)[4]) {
    const float C = 0.125f * 1.4426950408889634f;
    float e[32], rr[32];
#pragma unroll
    for (int i = 0; i < 32; ++i) { const float a = (i < 16) ? p0[i & 15] : p1[i & 15];
        float ev = __builtin_amdgcn_exp2f(fminf(a * C, 80.f)); float rv = __builtin_amdgcn_rcpf(1.f + ev);
        if (DIAG) { const int kidx = (i >> 4) * 32 + crow(i & 15, hi); const bool valid = kidx < tl; ev = valid ? ev : 0.f; rv = valid ? rv : 1.f; }
        e[i] = ev; rr[i] = rv; }
    float T[8];
#pragma unroll
    for (int g = 0; g < 8; ++g) { const float s3 = rr[4 * g + 3], s2 = rr[4 * g + 2] * s3, s1 = rr[4 * g + 1] * s2, s0 = rr[4 * g] * s1;
        e[4 * g + 3] *= s3; e[4 * g + 2] *= s2; e[4 * g + 1] *= s1; e[4 * g] *= s0; T[g] = s0; }
    float run = carry;
#pragma unroll
    for (int g = 7; g >= 0; --g) { auto sw = __builtin_amdgcn_permlane32_swap(__float_as_uint(T[g]), __float_as_uint(T[g]), false, false);
        const float T0 = __uint_as_float(sw[0]), T1 = __uint_as_float(sw[1]);
        const float off1 = run, off0 = run * T1; run = off0 * T0; const float off = hi ? off1 : off0;
        e[4 * g] *= off; e[4 * g + 1] *= off; e[4 * g + 2] *= off; e[4 * g + 3] *= off; }
    carry = run;
#pragma unroll
    for (int s = 0; s < 4; ++s) { u32x4 w; w.x = cvt_pk_bf16(e[8 * s], e[8 * s + 1]); w.y = cvt_pk_bf16(e[8 * s + 2], e[8 * s + 3]); w.z = cvt_pk_bf16(e[8 * s + 4], e[8 * s + 5]); w.w = cvt_pk_bf16(e[8 * s + 6], e[8 * s + 7]);
        pf[s] = __builtin_bit_cast(bf16x8, w); }
}

__device__ __forceinline__ unsigned sb_unit(const bf16_t* __restrict__ PROJ, bf16_t* __restrict__ MIX, int b, int h, int qt, LAS unsigned char* vl, int lane, unsigned* qw) {
    const int r32 = lane & 31, hi = lane >> 5;
    const size_t rowbase = (size_t)b * SEQ;
    const int t = qt * 32 + r32;
    const bf16_t* qp = PROJ + (rowbase + t) * 2560 + 1024 + h * 64 + hi * 8;
    const bf16_t* kg = PROJ + rowbase * 2560 + 1536 + h * 64;
    const bf16_t* vg = PROJ + rowbase * 2560 + 2048 + h * 64;
    const unsigned ksrc = (unsigned)((lane >> 3) * 2560 + (((lane & 7) ^ (lane >> 3)) * 8));
    const unsigned vsrc = (unsigned)((lane >> 2) * 2560 + (lane & 3) * 8);
#define SB_DMA_K(k0_) do { _Pragma("unroll") for (int i_ = 0; i_ < 8; ++i_) \
        __builtin_amdgcn_global_load_lds((const unsigned*)(kg + (size_t)((k0_) + 8 * i_) * 2560 + ksrc), (LAS unsigned*)(vl + i_ * 1024), 16, 0, 0); } while (0)
#define SB_DMA_V(k0_) do { _Pragma("unroll") for (int i_ = 0; i_ < 8; ++i_) \
        __builtin_amdgcn_global_load_lds((const unsigned*)(vg + (size_t)((k0_) + 16 * (i_ & 3)) * 2560 + 32 * (i_ >> 2) + vsrc), (LAS unsigned*)(vl + 8192 + i_ * 1024), 16, 0, 0); } while (0)
    asm volatile("s_waitcnt vmcnt(8)" ::: "memory");
    const int kt0 = qt >> 1;
    SB_DMA_K(kt0 * 64); SB_DMA_V(kt0 * 64);
    bf16x8 qf[4];
#pragma unroll
    for (int ks = 0; ks < 4; ++ks) qf[ks] = *(const bf16x8*)(qp + 16 * ks);
    f32x16 o0, o1;
#pragma unroll
    for (int r = 0; r < 16; ++r) { o0[r] = 0.f; o1[r] = 0.f; }
    float carry = 1.f;
    LAS const unsigned char* vrd = vl + 8192 + (4 * hi + ((lane & 15) >> 2)) * 64 + ((lane >> 4) & 1) * 32 + (lane & 3) * 8;
    for (int kt = kt0; kt >= 0; --kt) {
        const int k0 = kt * 64;
        asm volatile("s_waitcnt vmcnt(8)" ::: "memory");
        f32x16 p0, p1;
#pragma unroll
        for (int r = 0; r < 16; ++r) { p0[r] = 0.f; p1[r] = 0.f; }
        __builtin_amdgcn_s_setprio(1);
#pragma unroll
        for (int ks = 0; ks < 4; ++ks) { const int c = 2 * ks + hi;
            const bf16x8 ka = *(LAS const bf16x8*)(vl + r32 * 128 + ((c ^ (r32 & 7)) << 4)), kb = *(LAS const bf16x8*)(vl + (32 + r32) * 128 + ((c ^ (r32 & 7)) << 4));
            p0 = __builtin_amdgcn_mfma_f32_32x32x16_bf16(ka, qf[ks], p0, 0, 0, 0); p1 = __builtin_amdgcn_mfma_f32_32x32x16_bf16(kb, qf[ks], p1, 0, 0, 0); }
        __builtin_amdgcn_s_setprio(0);
        asm volatile("s_waitcnt lgkmcnt(0)" ::: "memory");
        if (kt > 0) SB_DMA_K(k0 - 64);
        bf16x8 pf[4];
        if (kt == kt0) sb_weights<true>(p0, p1, t - k0, hi, carry, pf); else sb_weights<false>(p0, p1, t - k0, hi, carry, pf);
        if (kt > 0) asm volatile("s_waitcnt vmcnt(8)" ::: "memory"); else asm volatile("s_waitcnt vmcnt(0)" ::: "memory");
        __builtin_amdgcn_s_setprio(1);
#pragma unroll
        for (int s = 0; s < 4; ++s) {
            const s16x4 a0 = vtr(vrd + s * 1024), a1 = vtr(vrd + s * 1024 + 512), c0 = vtr(vrd + 4096 + s * 1024), c1 = vtr(vrd + 4096 + s * 1024 + 512);
            const bf16x8 va = (bf16x8){a0[0], a0[1], a0[2], a0[3], a1[0], a1[1], a1[2], a1[3]}, vc = (bf16x8){c0[0], c0[1], c0[2], c0[3], c1[0], c1[1], c1[2], c1[3]};
            o0 = __builtin_amdgcn_mfma_f32_32x32x16_bf16(va, pf[s], o0, 0, 0, 0);
            o1 = __builtin_amdgcn_mfma_f32_32x32x16_bf16(vc, pf[s], o1, 0, 0, 0);
        }
        __builtin_amdgcn_s_setprio(0);
        asm volatile("s_waitcnt lgkmcnt(0)" ::: "memory");
        if (__all(carry < 1e-9f)) break;
        if (kt > 0) SB_DMA_V(k0 - 64);
    }
    unsigned nx = 0u; if (lane == 0) nx = atomicAdd(qw, 1u);
    bf16_t* op = MIX + (rowbase + t) * D_MODEL + 512 + h * 64 + 4 * hi;
#pragma unroll
    for (int g = 0; g < 4; ++g) {
        unsigned long long w0 = (unsigned long long)cvt_pk_bf16(o0[4 * g], o0[4 * g + 1]) | ((unsigned long long)cvt_pk_bf16(o0[4 * g + 2], o0[4 * g + 3]) << 32);
        unsigned long long w1 = (unsigned long long)cvt_pk_bf16(o1[4 * g], o1[4 * g + 1]) | ((unsigned long long)cvt_pk_bf16(o1[4 * g + 2], o1[4 * g + 3]) << 32);
        *(unsigned long long*)(op + 8 * g) = w0; *(unsigned long long*)(op + 32 + 8 * g) = w1; }
#undef SB_DMA_K
#undef SB_DMA_V
    return (unsigned)__builtin_amdgcn_readfirstlane((int)nx);
}
}


#define XB_TMO      128
#define XB_XCNT(j)  (256  + 64 * (j))
#define XB_XSUB(j)  (1280 + 64 * (j))
#define XB_XGEN(j)  (2304 + 64 * (j))
#define XB_TOP      3328
#define XB_TOPGEN   3392
#define XCD_BAR_WORDS 3456
#define XB_SPIN_CAP (1u << 18)
__device__ __forceinline__ unsigned xb_ld(unsigned* p)              { return __hip_atomic_load(p, __ATOMIC_RELAXED, __HIP_MEMORY_SCOPE_AGENT); }
__device__ __forceinline__ unsigned xb_add(unsigned* p, unsigned v) { return __hip_atomic_fetch_add(p, v, __ATOMIC_RELAXED, __HIP_MEMORY_SCOPE_AGENT); }
__device__ __forceinline__ unsigned xb_xcc_id() { return (unsigned)__builtin_amdgcn_s_getreg((3 << 11) | 20) & 0xFu; }
#define XB_SPIN(cond, bar) do { unsigned _sp = 0; while (cond) { __builtin_amdgcn_s_sleep(1); \
    if ((++_sp & 255u) == 0u) { if (xb_ld(&(bar)[XB_TMO])) break; if (_sp > XB_SPIN_CAP) { atomicAdd(&(bar)[XB_TMO], 1u); break; } } } } while (0)
struct XcdBarrier { unsigned* bar; unsigned x; volatile LAS unsigned* st; };
__device__ __forceinline__ XcdBarrier xcd_barrier_post(unsigned* bar, volatile LAS unsigned* st) {
    XcdBarrier b; b.bar = bar; b.x = xb_xcc_id(); b.st = st;
    if (threadIdx.x == 0) (void)xb_add(&bar[XB_XCNT(b.x)], 1u);
    return b;
}
__device__ __forceinline__ void xcd_barrier_complete(unsigned* bar, unsigned x, unsigned& nloc, unsigned& nx) {
    const unsigned G = gridDim.x * gridDim.y * gridDim.z;
    unsigned sum, cnt, mine, sp = 0u;
    for (;;) {
        sum = 0u; cnt = 0u; mine = 0u;
#pragma unroll
        for (unsigned j = 0; j < 16; ++j) { const unsigned c = xb_ld(&bar[XB_XCNT(j)]); sum += c; cnt += (c > 0u) ? 1u : 0u; mine = (j == x) ? c : mine; }
        if (sum == G) break;
        __builtin_amdgcn_s_sleep(1);
        if ((++sp & 255u) == 0u) { if (xb_ld(&bar[XB_TMO])) break; if (sp > XB_SPIN_CAP) { atomicAdd(&bar[XB_TMO], 1u); break; } }
    }
    nloc = mine > 0u ? mine : 1u; nx = cnt > 0u ? cnt : 1u;
}
__device__ __forceinline__ void xcd_barrier(const XcdBarrier& b) {
    asm volatile("s_waitcnt vmcnt(0)" ::: "memory");
    __syncthreads();
    if (threadIdx.x == 0) {
        unsigned* bar = b.bar;
        __builtin_amdgcn_s_waitcnt(0);
        unsigned nloc = b.st[0], nx = b.st[1];
        if (nloc == 0u) { xcd_barrier_complete(bar, b.x, nloc, nx); b.st[0] = nloc; b.st[1] = nx; }
        const unsigned old = xb_add(&bar[XB_XSUB(b.x)], 1u);
        const unsigned gen = old / nloc;
        if (old + 1u == (gen + 1u) * nloc) {
            __builtin_amdgcn_fence(__ATOMIC_RELEASE, "agent");
            asm volatile("s_waitcnt vmcnt(0)" ::: "memory");
            const unsigned og = xb_add(&bar[XB_TOP], 1u);
            const unsigned tg = og / nx;
            if (og + 1u == (tg + 1u) * nx) xb_add(&bar[XB_TOPGEN], 1u);
            else XB_SPIN(xb_ld(&bar[XB_TOPGEN]) == tg, bar);
            __builtin_amdgcn_fence(__ATOMIC_ACQUIRE, "agent");
            xb_add(&bar[XB_XGEN(b.x)], 1u);
            asm volatile("s_waitcnt vmcnt(0)" ::: "memory");
        } else {
            XB_SPIN(xb_ld(&bar[XB_XGEN(b.x)]) == gen, bar);
            __builtin_amdgcn_fence(__ATOMIC_ACQUIRE, "agent");
            asm volatile("s_waitcnt vmcnt(0)" ::: "memory");
        }
    }
    __syncthreads();
}

__device__ __forceinline__ void sub_barrier(unsigned* ctr, unsigned n) {
    asm volatile("s_waitcnt vmcnt(0)" ::: "memory");
    __syncthreads();
    if (threadIdx.x == 0) {
        __builtin_amdgcn_fence(__ATOMIC_RELEASE, "agent");
        asm volatile("s_waitcnt vmcnt(0)" ::: "memory");
        (void)xb_add(ctr, 1u);
        unsigned sp = 0u;
        while (xb_ld(ctr) < n) { __builtin_amdgcn_s_sleep(2); if (++sp > (1u << 22)) break; }
        __builtin_amdgcn_fence(__ATOMIC_ACQUIRE, "agent");
        asm volatile("s_waitcnt vmcnt(0)" ::: "memory");
    }
    __syncthreads();
}

__device__ __forceinline__ void sub_barrier_sh(unsigned* loc, unsigned nloc, unsigned* glob, unsigned nglob) {
    asm volatile("s_waitcnt vmcnt(0)" ::: "memory");
    __syncthreads();
    if (threadIdx.x == 0) {
        const unsigned old = xb_add(loc, 1u);
        if (old + 1u == nloc) { __builtin_amdgcn_fence(__ATOMIC_RELEASE, "agent"); asm volatile("s_waitcnt vmcnt(0)" ::: "memory"); (void)xb_add(glob, 1u); }
        unsigned sp = 0u;
        while (xb_ld(glob) < nglob) { __builtin_amdgcn_s_sleep(2); if (++sp > (1u << 22)) break; }
        __builtin_amdgcn_fence(__ATOMIC_ACQUIRE, "agent");
        asm volatile("s_waitcnt vmcnt(0)" ::: "memory");
    }
    __syncthreads();
}

struct NoPre { __device__ __forceinline__ void operator()() const {} };
template <class Pre = NoPre>
__device__ __forceinline__ void fam_barrier(unsigned* ctr, unsigned n, unsigned* glob = nullptr, const Pre& pre = Pre()) {
    asm volatile("s_waitcnt vmcnt(0)" ::: "memory");
    __syncthreads();
    pre();
    if (threadIdx.x == 0) {
        const unsigned old = xb_add(ctr, 1u);
        if (glob == nullptr) {
            if (old + 1u == n) (void)xb_add(ctr + 1, 1u);
            else { unsigned sp = 0u; while (xb_ld(ctr + 1) == 0u) { __builtin_amdgcn_s_sleep(1); if (++sp > (1u << 22)) break; } }
        } else {
            if (old + 1u == n) (void)xb_add(glob, 1u);
            asm volatile("buffer_inv sc1" ::: "memory");
            if (old + 1u == n) { unsigned sp = 0u; while (xb_ld(glob) < 8u) { __builtin_amdgcn_s_sleep(1); if (++sp > (1u << 22)) break; } (void)xb_add(ctr + 1, 1u); }
            else { unsigned sp = 0u; while (xb_ld(ctr + 1) == 0u) { __builtin_amdgcn_s_sleep(1); if (++sp > (1u << 22)) break; } }
            asm volatile("s_waitcnt vmcnt(0)" ::: "memory");
        }
    }
    __syncthreads();
}

constexpr int NWAVES = 8;
constexpr int RING_BYTES = 131072, LDS_BYTES = 147456;
constexpr int NPHASE = 14;
struct Args { const float* in[29]; float* out; unsigned char* ws; int ph_lo, ph_hi; };


namespace mbp {
typedef float f32x16 __attribute__((ext_vector_type(16)));
typedef short s16x4 __attribute__((ext_vector_type(4)));
constexpr int D = 128, NW = 8, QBLK = 32, KVBLK = 64, LD = 1536;
constexpr float SCALE = 0.088388347648318440f;
constexpr float THR = 8.f;
constexpr float NEG = -1e30f;
constexpr size_t SHM_V = KVBLK * D * 2, SHM_K = KVBLK * D * 2, SHM_ATTN = 2 * SHM_V + 2 * SHM_K + NW * 64 * 4 + 64;
#define KSWZ(row, colB) ((row) * 256 + ((colB) ^ (((row) & 7) << 4)))
#define SBAR() __builtin_amdgcn_sched_barrier(0)
__device__ __forceinline__ int crow(int r, int hi) { return (r & 3) + 8 * (r >> 2) + 4 * hi; }
__device__ __forceinline__ unsigned cvtpk(float lo, float hi) { unsigned r; asm volatile("v_cvt_pk_bf16_f32 %0, %1, %2" : "=v"(r) : "v"(lo), "v"(hi)); return r; }

__device__ __forceinline__ void partialSM(f32x16& p0, f32x16& p1, float& m_reg, float& mn, float& alpha) {
    constexpr float C = SCALE * 1.4426950408889634f;
    float pmax = p0[0];
#pragma unroll
    for (int r = 1; r < 16; ++r) pmax = fmaxf(pmax, p0[r]);
#pragma unroll
    for (int r = 0; r < 16; ++r) pmax = fmaxf(pmax, p1[r]);
    { auto rr = __builtin_amdgcn_permlane32_swap(__float_as_uint(pmax), __float_as_uint(pmax), false, false);
      pmax = fmaxf(__uint_as_float(rr[0]), __uint_as_float(rr[1])); }
    if (__builtin_expect(__all(pmax - m_reg <= THR / SCALE), 1)) { mn = m_reg; alpha = 1.f; }
    else { mn = fmaxf(m_reg, pmax); alpha = __builtin_amdgcn_exp2f((m_reg - mn) * C); m_reg = mn; }
    const float mnC = -mn * C;
#pragma unroll
    for (int r = 0; r < 16; ++r) p0[r] = fmaf(p0[r], C, mnC);
#pragma unroll
    for (int r = 0; r < 16; ++r) p1[r] = fmaf(p1[r], C, mnC);
#pragma unroll
    for (int r = 0; r < 16; ++r) p0[r] = __builtin_amdgcn_exp2f(p0[r]);
}
__device__ __forceinline__ void finishSM(f32x16& p0, f32x16& p1, float alpha, float& l_reg, bf16x8& pa0, bf16x8& pa1, bf16x8& pa2, bf16x8& pa3) {
#pragma unroll
    for (int r = 0; r < 16; ++r) p1[r] = __builtin_amdgcn_exp2f(p1[r]);
    float ps = 0;
#pragma unroll
    for (int r = 0; r < 16; ++r) ps += p0[r];
#pragma unroll
    for (int r = 0; r < 16; ++r) ps += p1[r];
    { auto rr = __builtin_amdgcn_permlane32_swap(__float_as_uint(ps), __float_as_uint(ps), false, false);
      ps = __uint_as_float(rr[0]) + __uint_as_float(rr[1]); }
    l_reg = l_reg * alpha + ps;
#define PK4(P, BASE, OUT) do { unsigned a0 = cvtpk(P[BASE + 0], P[BASE + 1]), a1 = cvtpk(P[BASE + 2], P[BASE + 3]);   \
    unsigned b0 = cvtpk(P[BASE + 4], P[BASE + 5]), b1 = cvtpk(P[BASE + 6], P[BASE + 7]);                              \
    auto r0 = __builtin_amdgcn_permlane32_swap(a0, b0, false, false); auto r1 = __builtin_amdgcn_permlane32_swap(a1, b1, false, false); \
    u32x4 w = {r0[0], r1[0], r0[1], r1[1]}; OUT = *reinterpret_cast<bf16x8*>(&w); } while (0)
    PK4(p0, 0, pa0); PK4(p0, 8, pa1); PK4(p1, 0, pa2); PK4(p1, 8, pa3);
#undef PK4
}
__device__ __forceinline__ void qkt(f32x16& p0, f32x16& p1, const bf16_t* Ks, const bf16x8* qr, int r32, int hi, float base, float cs) {
    const char* kb = (const char*)Ks;
#define KRD(d0) *reinterpret_cast<const bf16x8*>(kb + KSWZ(r32, ((d0) * 16 + hi * 8) * 2))
#define KRD2(d0) *reinterpret_cast<const bf16x8*>(kb + KSWZ(32 + r32, ((d0) * 16 + hi * 8) * 2))
    bf16x8 ka[3], kc[3];
    ka[0] = KRD(0); kc[0] = KRD2(0); ka[1] = KRD(1); kc[1] = KRD2(1);
#pragma unroll
    for (int r = 0; r < 16; ++r) { p0[r] = fmaf(cs, (float)((r & 3) + 8 * (r >> 2)), base); p1[r] = fmaf(cs, (float)(32 + (r & 3) + 8 * (r >> 2)), base); }
    SBAR();
#pragma unroll
    for (int d0 = 0; d0 < 8; ++d0) {
        if (d0 + 2 < 8) { ka[(d0 + 2) % 3] = KRD(d0 + 2); kc[(d0 + 2) % 3] = KRD2(d0 + 2); }
        SBAR();
        p0 = __builtin_amdgcn_mfma_f32_32x32x16_bf16(ka[d0 % 3], qr[d0], p0, 0, 0, 0);
        p1 = __builtin_amdgcn_mfma_f32_32x32x16_bf16(kc[d0 % 3], qr[d0], p1, 0, 0, 0);
        SBAR();
    }
#undef KRD
#undef KRD2
}
__device__ __forceinline__ int v_st(int k, int c) { const int kk = (k & ~0xC) | ((k & 4) << 1) | ((k & 8) >> 1); return ((kk >> 3) * 4 + (c >> 5)) * 512 + ((kk & 7) * 32 + (c & 31)) * 2; }
__device__ __forceinline__ int v_rd_base(int lane) { return ((lane & 3) << 3) | (((lane >> 2) & 3) << 6) | (((lane >> 4) & 1) << 5) | (((lane >> 5) & 1) << 8); }
constexpr int v_rd_off(int d0, int ks, int half) { return d0 * 512 + ks * 4096 + half * 2048; }
template <int OFF> __device__ __forceinline__ s16x4 tr_read(int vb) { s16x4 r; asm volatile("ds_read_b64_tr_b16 %0, %1 offset:%2" : "=&v"(r) : "v"(vb), "i"(OFF) : "memory"); return r; }
template <int D0> __device__ __forceinline__ void pv_one(f32x16& od, int vb, bf16x8 pa0, bf16x8 pa1, bf16x8 pa2, bf16x8 pa3) {
    const s16x4 l0 = tr_read<v_rd_off(D0, 0, 0)>(vb), h0 = tr_read<v_rd_off(D0, 0, 1)>(vb), l1 = tr_read<v_rd_off(D0, 1, 0)>(vb), h1 = tr_read<v_rd_off(D0, 1, 1)>(vb);
    const s16x4 l2 = tr_read<v_rd_off(D0, 2, 0)>(vb), h2 = tr_read<v_rd_off(D0, 2, 1)>(vb), l3 = tr_read<v_rd_off(D0, 3, 0)>(vb), h3 = tr_read<v_rd_off(D0, 3, 1)>(vb);
    asm volatile("s_waitcnt lgkmcnt(0)" ::: "memory"); SBAR();
#define PK(L, H) (bf16x8){L[0], L[1], L[2], L[3], H[0], H[1], H[2], H[3]}
    od = __builtin_amdgcn_mfma_f32_32x32x16_bf16(pa0, PK(l0, h0), od, 0, 0, 0);
    od = __builtin_amdgcn_mfma_f32_32x32x16_bf16(pa1, PK(l1, h1), od, 0, 0, 0);
    od = __builtin_amdgcn_mfma_f32_32x32x16_bf16(pa2, PK(l2, h2), od, 0, 0, 0);
    od = __builtin_amdgcn_mfma_f32_32x32x16_bf16(pa3, PK(l3, h3), od, 0, 0, 0);
#undef PK
}
struct VFrag { s16x4 l0, h0, l1, h1, l2, h2, l3, h3; };
typedef short v4i16m_t __attribute__((ext_vector_type(4)));
template <int OFF> __device__ __forceinline__ s16x4 tr_rd(int vb) { return __builtin_bit_cast(s16x4, __builtin_amdgcn_ds_read_tr16_b64_v4i16((LAS v4i16m_t*)(unsigned)(vb + OFF))); }
template <int D0> __device__ __forceinline__ void v_reads(VFrag& f, int vb) {
    f.l0 = tr_rd<v_rd_off(D0, 0, 0)>(vb); f.h0 = tr_rd<v_rd_off(D0, 0, 1)>(vb); f.l1 = tr_rd<v_rd_off(D0, 1, 0)>(vb); f.h1 = tr_rd<v_rd_off(D0, 1, 1)>(vb);
    f.l2 = tr_rd<v_rd_off(D0, 2, 0)>(vb); f.h2 = tr_rd<v_rd_off(D0, 2, 1)>(vb); f.l3 = tr_rd<v_rd_off(D0, 3, 0)>(vb); f.h3 = tr_rd<v_rd_off(D0, 3, 1)>(vb);
}
__device__ __forceinline__ void v_mma(f32x16& od, const VFrag& f, bf16x8 pa0, bf16x8 pa1, bf16x8 pa2, bf16x8 pa3) {
#define PK(L, H) (bf16x8){L[0], L[1], L[2], L[3], H[0], H[1], H[2], H[3]}
    od = __builtin_amdgcn_mfma_f32_32x32x16_bf16(pa0, PK(f.l0, f.h0), od, 0, 0, 0);
    od = __builtin_amdgcn_mfma_f32_32x32x16_bf16(pa1, PK(f.l1, f.h1), od, 0, 0, 0);
    od = __builtin_amdgcn_mfma_f32_32x32x16_bf16(pa2, PK(f.l2, f.h2), od, 0, 0, 0);
    od = __builtin_amdgcn_mfma_f32_32x32x16_bf16(pa3, PK(f.l3, f.h3), od, 0, 0, 0);
#undef PK
}
__device__ __forceinline__ void pv_d0_pre(f32x16* o, int vb, VFrag& fa, bf16x8 pa0, bf16x8 pa1, bf16x8 pa2, bf16x8 pa3) {
    VFrag fb;
    v_reads<1>(fb, vb); SBAR(); v_mma(o[0], fa, pa0, pa1, pa2, pa3); SBAR();
    v_reads<2>(fa, vb); SBAR(); v_mma(o[1], fb, pa0, pa1, pa2, pa3); SBAR();
    v_reads<3>(fb, vb); SBAR(); v_mma(o[2], fa, pa0, pa1, pa2, pa3); SBAR();
    v_mma(o[3], fb, pa0, pa1, pa2, pa3);
}
__device__ __forceinline__ void pv_d0(f32x16* o, int vb, bf16x8 pa0, bf16x8 pa1, bf16x8 pa2, bf16x8 pa3) {
    pv_one<0>(o[0], vb, pa0, pa1, pa2, pa3); pv_one<1>(o[1], vb, pa0, pa1, pa2, pa3); pv_one<2>(o[2], vb, pa0, pa1, pa2, pa3); pv_one<3>(o[3], vb, pa0, pa1, pa2, pa3);
}

constexpr int SLOT_BYTES = 32768, NSLOT = 4, OFF_WSF = NSLOT * SLOT_BYTES, OFF_NEED = OFF_WSF + NW * 64 * 4;
__device__ __forceinline__ void moba_unit(const bf16_t* __restrict__ QKV, const float* __restrict__ KM, const float* __restrict__ KN2, bf16_t* __restrict__ MIX, int b, int h, int qb, char* lds, LAS unsigned char* ldsL, unsigned* qw, volatile LAS unsigned* uq) {
    const int tid = threadIdx.x, wid = __builtin_amdgcn_readfirstlane(tid >> 6), lane = tid & 63, r32 = lane & 31, hi = lane >> 5;
    float* wsf = (float*)(lds + OFF_WSF) + wid * 64; float* li_l = wsf; float* al_l = wsf + 32;
    unsigned* need_l = (unsigned*)(lds + OFF_NEED);
    const size_t rowbase = (size_t)b * SEQ; const int q0 = qb * 256;
    const bf16_t* Qb = QKV + (rowbase + q0) * LD + h * D;
    const bf16_t* Kh = QKV + rowbase * LD + 512 + h * D;
    const bf16_t* Vh = QKV + rowbase * LD + 1024 + h * D;
    float m_reg = NEG, l_reg = 0; f32x16 o[4];
#pragma unroll
    for (int d = 0; d < 4; ++d)
#pragma unroll
        for (int r = 0; r < 16; ++r) o[d][r] = 0.f;
    bf16x8 qr[8];
    const bf16_t* Qw = Qb + (size_t)(wid * QBLK + r32) * LD + hi * 8;
#pragma unroll
    for (int d0 = 0; d0 < 8; ++d0) qr[d0] = *reinterpret_cast<const bf16x8*>(Qw + d0 * 16);
    unsigned sel = 0u;
    if (qb > 0) {
        f32x16 gs;
#pragma unroll
        for (int r = 0; r < 16; ++r) gs[r] = 0.f;
        const float* km = KM + ((size_t)((b * 4 + h) * 16 + (r32 & 15)) * 128) + hi * 8;
        const bool rowok = r32 < qb;
#pragma unroll
        for (int d0 = 0; d0 < 8; ++d0) { f32x4 k0v = *(const f32x4*)(km + d0 * 16), k1v = *(const f32x4*)(km + d0 * 16 + 4);
            if (!rowok) { k0v = (f32x4){0.f, 0.f, 0.f, 0.f}; k1v = k0v; }
            u32x4 whi, wlo; float rem[8];
            whi.x = pk2(k0v[0], k0v[1]); whi.y = pk2(k0v[2], k0v[3]); whi.z = pk2(k1v[0], k1v[1]); whi.w = pk2(k1v[2], k1v[3]);
            rem[0] = k0v[0] - __uint_as_float(whi.x << 16); rem[1] = k0v[1] - __uint_as_float(whi.x & 0xffff0000u);
            rem[2] = k0v[2] - __uint_as_float(whi.y << 16); rem[3] = k0v[3] - __uint_as_float(whi.y & 0xffff0000u);
            rem[4] = k1v[0] - __uint_as_float(whi.z << 16); rem[5] = k1v[1] - __uint_as_float(whi.z & 0xffff0000u);
            rem[6] = k1v[2] - __uint_as_float(whi.w << 16); rem[7] = k1v[3] - __uint_as_float(whi.w & 0xffff0000u);
            wlo.x = pk2(rem[0], rem[1]); wlo.y = pk2(rem[2], rem[3]); wlo.z = pk2(rem[4], rem[5]); wlo.w = pk2(rem[6], rem[7]);
            gs = __builtin_amdgcn_mfma_f32_32x32x16_bf16(__builtin_bit_cast(bf16x8, whi), qr[d0], gs, 0, 0, 0);
            gs = __builtin_amdgcn_mfma_f32_32x32x16_bf16(__builtin_bit_cast(bf16x8, wlo), qr[d0], gs, 0, 0, 0); }
        float G[16];
#pragma unroll
        for (int r = 0; r < 8; ++r) { auto sw = __builtin_amdgcn_permlane32_swap(__float_as_uint(gs[r]), __float_as_uint(gs[r]), false, false);
            G[(r & 3) + 8 * (r >> 2)] = __uint_as_float(sw[0]); G[(r & 3) + 8 * (r >> 2) + 4] = __uint_as_float(sw[1]); }
#pragma unroll
        for (int rep = 0; rep < 3; ++rep) { int bi = -1; float bv = -INFINITY;
#pragma unroll
            for (int j = 0; j < 16; ++j) if (j < qb && !((sel >> j) & 1u) && (bi < 0 || G[j] > bv)) { bi = j; bv = G[j]; }
            if (bi >= 0) sel |= 1u << bi; }
    }
    float qn2 = 0.f;
#pragma unroll
    for (int d0 = 0; d0 < 8; ++d0) { const u32x4 w = __builtin_bit_cast(u32x4, qr[d0]);
        const float a0 = __uint_as_float(w.x << 16), a1 = __uint_as_float(w.x & 0xffff0000u), a2 = __uint_as_float(w.y << 16), a3 = __uint_as_float(w.y & 0xffff0000u);
        const float a4 = __uint_as_float(w.z << 16), a5 = __uint_as_float(w.z & 0xffff0000u), a6 = __uint_as_float(w.w << 16), a7 = __uint_as_float(w.w & 0xffff0000u);
        qn2 += (a0 * a0 + a1 * a1) + (a2 * a2 + a3 * a3) + (a4 * a4 + a5 * a5) + (a6 * a6 + a7 * a7); }
    { auto sw = __builtin_amdgcn_permlane32_swap(__float_as_uint(qn2), __float_as_uint(qn2), false, false); qn2 = __uint_as_float(sw[0]) + __uint_as_float(sw[1]); }
    float kn2 = 0.f;
    for (int sx = tid; sx < q0 + 256; sx += 512) kn2 = fmaxf(kn2, KN2[(rowbase + sx) * 4 + h]);
    __syncthreads();
    if (tid == 0) { need_l[0] = 0u; need_l[2] = 0u; need_l[3] = 0u; }
    __syncthreads();
    if (sel) atomicOr(need_l, sel);
    atomicMax(need_l + 2, __float_as_uint(kn2)); atomicMax(need_l + 3, __float_as_uint(qn2));
    __syncthreads();
    const unsigned need = (unsigned)__builtin_amdgcn_readfirstlane((int)need_l[0]);
    const float slope = (h == 0) ? 0.25f : (h == 1) ? 0.0625f : (h == 2) ? 0.015625f : 0.00390625f;
    const float smax = sqrtf(__uint_as_float((unsigned)__builtin_amdgcn_readfirstlane((int)need_l[2])) * __uint_as_float((unsigned)__builtin_amdgcn_readfirstlane((int)need_l[3]))) * SCALE * 1.02f;
    const float dthr = (2.f * smax + 30.f) / slope;
    unsigned long long blist = (unsigned long long)qb; int nblk = 1;
    for (int j = qb - 1; j >= 0; --j) if (((need >> j) & 1u) && !((float)(q0 - 256 * j - 255) > dthr)) { blist |= (unsigned long long)j << (4 * nblk); ++nblk; }
    nblk = __builtin_amdgcn_readfirstlane(nblk);
    const int NT = 4 * nblk;
    const int tq = q0 + wid * QBLK + r32;
    const float cs = slope / SCALE;
#define TILE_BLK(n) ((int)((blist >> (4 * ((n) >> 2))) & 15ull))
#define TILE_K0(n) (TILE_BLK(n) * 256 + ((n) & 3) * KVBLK)
    unsigned ksrc[2], vsrc[2];
#pragma unroll
    for (int i = 0; i < 2; ++i) { const int ci = (wid * 2 + i) * 64 + lane; const int row = ci >> 4, c = (ci & 15) ^ (row & 7); ksrc[i] = (unsigned)(row * LD + c * 8);
        const int st = ci >> 5, rr = (ci & 31) >> 2, cc = ci & 3; const int kk = (st >> 2) * 8 + rr; const int k = (kk & ~0xC) | ((kk & 4) << 1) | ((kk & 8) >> 1);
        vsrc[i] = (unsigned)(k * LD + (st & 3) * 32 + cc * 8); }
#define DMA_TILE(n, slot) do { const int k0_ = TILE_K0(n); const bf16_t* kg_ = Kh + (size_t)k0_ * LD; const bf16_t* vg_ = Vh + (size_t)k0_ * LD; \
    _Pragma("unroll") for (int i_ = 0; i_ < 2; ++i_) { \
        __builtin_amdgcn_global_load_lds((const unsigned*)(kg_ + ksrc[i_]), (LAS unsigned*)(ldsL + (slot) * SLOT_BYTES + (wid * 2 + i_) * 1024), 16, 0, 0); \
        __builtin_amdgcn_global_load_lds((const unsigned*)(vg_ + vsrc[i_]), (LAS unsigned*)(ldsL + (slot) * SLOT_BYTES + 16384 + (wid * 2 + i_) * 1024), 16, 0, 0); } } while (0)
    const int vb0 = (int)(uintptr_t)lds + 16384 + v_rd_base(lane);
    DMA_TILE(0, 0); DMA_TILE(1, 1);
    int slot = 0; bool pend = false; int pslot = 0; bf16x8 pa0, pa1, pa2, pa3;
    asm volatile("s_waitcnt vmcnt(4)" ::: "memory");
    if (wid >= 4) __builtin_amdgcn_s_barrier();
    for (int t = 0; t < NT; ++t) {
        if (t + 1 < NT) asm volatile("s_waitcnt vmcnt(4)" ::: "memory"); else asm volatile("s_waitcnt vmcnt(0)" ::: "memory");
        __builtin_amdgcn_s_barrier();
        if (t + 2 < NT) { const int s2 = (slot + 2) & 3; DMA_TILE(t + 2, s2); }
        const int blk = TILE_BLK(t), k0 = blk * 256 + (t & 3) * KVBLK;
        const bool own = (t >> 2) == 0;
        const bool allowed = own || ((sel >> blk) & 1u);
        const bool skip = own ? (k0 > q0 + wid * QBLK + QBLK - 1) : !__any(allowed);
        f32x16 p0, p1;
        __builtin_amdgcn_s_setprio(1);
        VFrag fa;
        if (pend) { v_reads<0>(fa, vb0 + pslot * SLOT_BYTES); }
        if (!skip) {
            const float base = fmaf(-cs, (float)(tq - k0 - 4 * hi), allowed ? 0.f : NEG);
            qkt(p0, p1, (const bf16_t*)(lds + slot * SLOT_BYTES), qr, r32, hi, base, cs);
        }
        if (pend) pv_d0_pre(o, vb0 + pslot * SLOT_BYTES, fa, pa0, pa1, pa2, pa3);
        __builtin_amdgcn_s_setprio(0);
        pend = !skip;
        if (t + 2 < NT) asm volatile("s_waitcnt vmcnt(4)" ::: "memory"); else asm volatile("s_waitcnt vmcnt(0)" ::: "memory");
        asm volatile("s_waitcnt lgkmcnt(0)" ::: "memory");
        __builtin_amdgcn_s_barrier();
        if (!skip) {
            float mn, alpha;
            if (__builtin_amdgcn_readfirstlane((int)(own && k0 + 63 > q0 + wid * QBLK))) {
                asm volatile("" ::: "memory");
#pragma unroll
                for (int r = 0; r < 16; ++r) { const int kv = k0 + crow(r, hi); if (kv > tq) p0[r] = NEG; if (kv + 32 > tq) p1[r] = NEG; } }
            partialSM(p0, p1, m_reg, mn, alpha);
            finishSM(p0, p1, alpha, l_reg, pa0, pa1, pa2, pa3);
            if (__any(alpha < 1.f)) { if (hi == 0) al_l[r32] = alpha; asm volatile("s_waitcnt lgkmcnt(0)" ::: "memory");
#pragma unroll
                for (int d = 0; d < 4; ++d)
#pragma unroll
                    for (int r = 0; r < 16; ++r) o[d][r] *= al_l[crow(r, hi)]; }
            pslot = slot;
        }
        slot = (slot + 1) & 3;
    }
    if (wid < 4) __builtin_amdgcn_s_barrier();
    if (pend) pv_d0(o, vb0 + pslot * SLOT_BYTES, pa0, pa1, pa2, pa3);
    if (hi == 0) li_l[r32] = l_reg; asm volatile("s_waitcnt lgkmcnt(0)" ::: "memory");
    float rli[16];
#pragma unroll
    for (int r = 0; r < 16; ++r) rli[r] = __builtin_amdgcn_rcpf(li_l[crow(r, hi)]);
    unsigned nxu = 0u; if (tid == 0) nxu = atomicAdd(qw, 1u);
    bf16_t* Ow = MIX + (rowbase + q0 + wid * QBLK) * D_MODEL + 512 + h * D;
#pragma unroll
    for (int r = 0; r < 16; ++r) { const int orow = crow(r, hi);
#pragma unroll
        for (int d0 = 0; d0 < 4; ++d0) Ow[(size_t)orow * D_MODEL + d0 * 32 + r32] = (bf16_t)f2bf(o[d0][r] * rli[r]); }
    if (tid == 0) uq[0] = nxu;
#undef TILE_BLK
#undef TILE_K0
#undef DMA_TILE
}
#undef KSWZ
#undef SBAR
}

namespace rgp {
typedef float f32x16 __attribute__((ext_vector_type(16)));
constexpr int XS_BYTES = 33 * 1024;
constexpr int OFF_XS = 0;
constexpr int OFF_GS = 2 * XS_BYTES;
constexpr int OFF_WL = OFF_GS + 32768;
constexpr int OFF_CW = OFF_WL + 32768;
constexpr int OFF_SM = OFF_CW + 1280;
__device__ __forceinline__ float lo16(unsigned w) { return __uint_as_float(w << 16); }
__device__ __forceinline__ float hi16(unsigned w) { return __uint_as_float(w & 0xffff0000u); }
#define RG_LBAR() do { asm volatile("s_waitcnt lgkmcnt(0)" ::: "memory"); __builtin_amdgcn_s_barrier(); asm volatile("" ::: "memory"); } while (0)

__device__ __forceinline__ void rg_unit(const Args& a, const bf16_t* __restrict__ PROJ, bf16_t* __restrict__ MIX, int b, int hd, int jb, LAS unsigned char* lds) {
    const int tid = threadIdx.x, lane = tid & 63, wave = __builtin_amdgcn_readfirstlane(tid >> 6), r32 = lane & 31, hi = lane >> 5;
    const float* conv_w = a.in[3]; const float* conv_b = a.in[4]; const float* wa = a.in[5]; const float* ba = a.in[6];
    const float* wx = a.in[7]; const float* bx = a.in[8]; const float* lam = a.in[9];
    const size_t rowbase = (size_t)b * SEQ;
    typedef float f32x2 __attribute__((ext_vector_type(2)));
    LAS f32x2* SM = (LAS f32x2*)(lds + OFF_SM);
    __syncthreads();
    { const int gate = tid >> 8, ks = (tid >> 6) & 3, h2 = (tid >> 5) & 1, j = tid & 31;
      const float* W = (gate ? wx : wa) + ((size_t)(hd * 64 + 16 * ks + 8 * h2) * 64 + 32 * jb + j);
      float v[8];
#pragma unroll
      for (int e = 0; e < 8; ++e) v[e] = W[e * 64];
#pragma unroll
      for (int k = 0; k < 4; ++k) { const float* cwp = conv_w + k * 512 + hd * 64 + 16 * ks + 8 * h2; float t[8];
#pragma unroll
          for (int e = 0; e < 8; ++e) t[e] = v[e] * cwp[e];
          u32x4 o; o.x = pk2(t[0], t[1]); o.y = pk2(t[2], t[3]); o.z = pk2(t[4], t[5]); o.w = pk2(t[6], t[7]);
          *(LAS u32x4*)(lds + OFF_WL + (k * 512 + tid) * 16) = o; } }
    const int cj = hd * 64 + 32 * jb + r32;
    float cwk[4];
#pragma unroll
    for (int k = 0; k < 4; ++k) cwk[k] = conv_w[k * 512 + cj];
    const float cbj = conv_b[cj]; float baj = ba[cj], bxj = bx[cj];
    { const float* Wa = wa + (size_t)(hd * 64) * 64 + 32 * jb + r32; const float* Wx = wx + (size_t)(hd * 64) * 64 + 32 * jb + r32; const float* cbh = conv_b + hd * 64;
#pragma unroll 16
      for (int c = 0; c < 64; ++c) { const float cbv = cbh[c]; baj = fmaf(Wa[c * 64], cbv, baj); bxj = fmaf(Wx[c * 64], cbv, bxj); } }
    const float lj = lam[cj];
    const float c8sp = -8.f * 1.4426950408889634f * (fmaxf(-lj, 0.f) + log1pf(expf(-fabsf(lj))));
    const unsigned xsrc = (unsigned)((lane >> 3) * 2560 + (((lane & 7) ^ (lane >> 3)) * 8));
    const unsigned gsrc = (unsigned)((lane >> 2) * 2560 + (lane & 3) * 8);
    const bf16_t* xg0 = PROJ + (rowbase) * 2560 + hd * 64;
    const bf16_t* gg0 = PROJ + (rowbase) * 2560 + 512 + hd * 64 + 32 * jb;
#define RG_DMA(st_, par_) do { \
    for (int i_ = wave; i_ < 33; i_ += 8) __builtin_amdgcn_global_load_lds((const unsigned*)(xg0 + (ptrdiff_t)(256 * (st_) - 3 + 8 * i_) * 2560 + xsrc), (LAS unsigned*)(lds + OFF_XS + (par_) * XS_BYTES + i_ * 1024), 16, 0, 0); \
    _Pragma("unroll") for (int i_ = 0; i_ < 2; ++i_) __builtin_amdgcn_global_load_lds((const unsigned*)(gg0 + (size_t)(256 * (st_) + 16 * (wave * 2 + i_)) * 2560 + gsrc), (LAS unsigned*)(lds + OFF_GS + (par_) * 16384 + (wave * 2 + i_) * 1024), 16, 0, 0); } while (0)
    float STc = 0.f;
    RG_DMA(0, 0);
    for (int st = 0; st < 16; ++st) {
        const int par = st & 1;
        LAS const unsigned char* xs = lds + OFF_XS + par * XS_BYTES;
        asm volatile("s_waitcnt vmcnt(0)" ::: "memory"); RG_LBAR();
        if (st + 1 < 16) RG_DMA(st + 1, par ^ 1);
        const bool first = (st == 0);
        f32x16 ga, gx;
#pragma unroll
        for (int r = 0; r < 16; ++r) { ga[r] = baj; gx[r] = bxj; }
#pragma unroll
        for (int k = 0; k < 4; ++k)
#pragma unroll
            for (int ks = 0; ks < 4; ++ks) { const int row = 32 * wave + r32 + k;
                u32x4 xv = *(LAS const u32x4*)(xs + row * 128 + (((2 * ks + hi) ^ (row & 7)) << 4));
                if (first && row < 3) xv = (u32x4){0u, 0u, 0u, 0u};
                const bf16x8 w0 = *(LAS const bf16x8*)(lds + OFF_WL + (k * 512 + ((0 * 4 + ks) * 2 + hi) * 32 + r32) * 16);
                const bf16x8 w1 = *(LAS const bf16x8*)(lds + OFF_WL + (k * 512 + ((1 * 4 + ks) * 2 + hi) * 32 + r32) * 16);
                ga = __builtin_amdgcn_mfma_f32_32x32x16_bf16(__builtin_bit_cast(bf16x8, xv), w0, ga, 0, 0, 0);
                gx = __builtin_amdgcn_mfma_f32_32x32x16_bf16(__builtin_bit_cast(bf16x8, xv), w1, gx, 0, 0, 0); }
        float hl[16], Pl[16], inH[4], inA[4];
        float cumA = 1.f, cumH = 0.f;
        const int cch = (32 * jb + r32) >> 3, cwi = (r32 & 7) * 2;
#pragma unroll
        for (int g = 0; g < 4; ++g) {
            float xv[7];
#pragma unroll
            for (int m = 0; m < 7; ++m) { const int row = 32 * wave + 8 * g + 4 * hi + m;
                xv[m] = bf2f(*(LAS const bf16_t*)(xs + row * 128 + ((cch ^ (row & 7)) << 4) + cwi)); if (first && row < 3) xv[m] = 0.f; }
            float A_ = 1.f, H_ = 0.f;
#pragma unroll
            for (int i = 0; i < 4; ++i) { const int r = 4 * g + i;
                const float xc = cbj + cwk[0] * xv[i] + cwk[1] * xv[i + 1] + cwk[2] * xv[i + 2] + cwk[3] * xv[i + 3];
                const float rg = fast_sigmoid(ga[r]), ig = fast_sigmoid(gx[r]);
                const float la2 = c8sp * rg; const float av = __builtin_amdgcn_exp2f(la2);
                const float x2 = la2 * 1.3862943611198906f;
                const float om = (x2 > -0.25f) ? -x2 * (1.f + x2 * (0.5f + x2 * (0.16666667f + x2 * (0.041666668f + x2 * 0.0083333338f)))) : 1.f - av * av;
                const float bv = __builtin_amdgcn_sqrtf(om) * ig * xc;
                H_ = av * H_ + bv; A_ = av * A_; hl[r] = H_; Pl[r] = A_; }
            auto swA = __builtin_amdgcn_permlane32_swap(__float_as_uint(A_), __float_as_uint(A_), false, false);
            auto swH = __builtin_amdgcn_permlane32_swap(__float_as_uint(H_), __float_as_uint(H_), false, false);
            const float A0 = __uint_as_float(swA[0]), A1 = __uint_as_float(swA[1]), H0 = __uint_as_float(swH[0]), H1 = __uint_as_float(swH[1]);
            const float in1H = A0 * cumH + H0, in1A = A0 * cumA;
            inH[g] = hi ? in1H : cumH; inA[g] = hi ? in1A : cumA;
            cumH = A1 * in1H + H1; cumA = A1 * in1A; }
        if (hi == 0) SM[(par * 8 + wave) * 32 + r32] = (f32x2){cumA, cumH};
        RG_LBAR();
        float xst = STc, myHin = 0.f;
#pragma unroll
        for (int w2 = 0; w2 < 8; ++w2) { const f32x2 sm = SM[(par * 8 + w2) * 32 + r32]; if (w2 == wave) myHin = xst; xst = sm.x * xst + sm.y; }
        STc = xst;
#pragma unroll
        for (int g = 0; g < 4; ++g) { const float inT = inH[g] + inA[g] * myHin;
#pragma unroll
            for (int i = 0; i < 4; ++i) { const int r = 4 * g + i, tt = 8 * g + 4 * hi + i;
                const float h = hl[r] + Pl[r] * inT;
                LAS bf16_t* gp = (LAS bf16_t*)(lds + OFF_GS + par * 16384 + (32 * wave + tt) * 64 + r32 * 2);
                const float gt = bf2f(*gp); *gp = (bf16_t)f2bf(h * gelu_tanh_fast(gt)); } }
        RG_LBAR();
        for (int i = tid; i < 1024; i += 512) { const int row = i >> 2, ch = i & 3;
            *(u32x4*)(MIX + (rowbase + 256 * st + row) * D_MODEL + hd * 64 + 32 * jb + ch * 8) = *(LAS const u32x4*)(lds + OFF_GS + par * 16384 + row * 64 + ch * 16); }
    }
    asm volatile("s_waitcnt vmcnt(0)" ::: "memory");
    __syncthreads();
#undef RG_DMA
}
#undef RG_LBAR
}

__device__ __forceinline__ void p0_transpose_item(const float* W, int K, int N, bf16_t* WT, const float* sc, int mode, LAS float* scr, int item, int lane) {
    const int nblk = N / 32, kb = item / nblk, nb = item % nblk, k0 = 64 * kb, n0 = 32 * nb;
    f32x4 v[8];
#pragma unroll
    for (int i = 0; i < 8; ++i) { const int kk = 8 * i + (lane >> 3); v[i] = __builtin_nontemporal_load((const f32x4*)(W + (size_t)(k0 + kk) * N + n0 + (lane & 7) * 4)); }
#pragma unroll
    for (int i = 0; i < 8; ++i) { const int kk = 8 * i + (lane >> 3); f32x4 w = v[i]; if (sc) w = w * sc[k0 + kk];
        LAS float* d = scr + kk * 33 + (lane & 7) * 4; d[0] = w[0]; d[1] = w[1]; d[2] = w[2]; d[3] = w[3]; }
    asm volatile("s_waitcnt lgkmcnt(0)" ::: "memory");
    const int c = lane & 7;
    const int rbase = (mode == 0) ? n0 : ((n0 >> 7) * 256 + (mode == 2 ? 128 : 0) + (n0 & 127));
#pragma unroll
    for (int j = 0; j < 4; ++j) { const int n = (lane >> 3) + 8 * j; const LAS float* s = scr + (8 * c) * 33 + n;
        u32x4 o; o.x = pk2(s[0 * 33], s[1 * 33]); o.y = pk2(s[2 * 33], s[3 * 33]); o.z = pk2(s[4 * 33], s[5 * 33]); o.w = pk2(s[6 * 33], s[7 * 33]);
        *(u32x4*)(WT + (size_t)(rbase + n) * K + k0 + 8 * c) = o; }
    asm volatile("s_waitcnt lgkmcnt(0)" ::: "memory");
}
struct TrJob { const float* W; int K, N; bf16_t* WT; const float* sc; int mode; int items; };

__device__ __forceinline__ void p0_s5_ops(const Args& a, LAS unsigned char* lds, int g, int q8) {
    typedef float f32x2 __attribute__((ext_vector_type(2)));
    LAS f32x2* pw = (LAS f32x2*)lds;
    LAS f32x2* Bb = (LAS f32x2*)(lds + 33 * 64 * 8);
    LAS f32x2* Cc = (LAS f32x2*)(lds + 33 * 64 * 8 + 8192);
    LAS float* Kt = (LAS float*)(lds + 33 * 64 * 8 + 16384);
    const int tid = threadIdx.x;
    const float* lam_re = a.in[13]; const float* lam_im = a.in[14]; const float* log_dt = a.in[15];
    const float* b_re = a.in[16]; const float* b_im = a.in[17]; const float* c_re = a.in[18]; const float* c_im = a.in[19];
    bf16_t* Eg = (bf16_t*)(a.ws + WS_E) + (size_t)g * 256 * 512;
    bf16_t* TCg = (bf16_t*)(a.ws + WS_TC) + (size_t)g * 512 * 640;
    __syncthreads();
    if (tid < 64) {
        const int n = tid;
        const double dt = exp((double)log_dt[g]), lr = (double)lam_re[g * 64 + n], li = (double)lam_im[g * 64 + n];
        const double mag = exp(lr * dt); double sn, cs; sincos(li * dt, &sn, &cs);
        const double are = mag * cs, aim = mag * sn;
        const double den = lr * lr + li * li, nr = are - 1.0, ni = aim;
        const double fre = (nr * lr + ni * li) / den, fim = (ni * lr - nr * li) / den;
        double pr = 1.0, pi = 0.0;
        for (int d = 0; d <= 32; ++d) { pw[d * 64 + n] = (f32x2){(float)pr, (float)pi}; const double t = pr * are - pi * aim; pi = pr * aim + pi * are; pr = t; }
        if (q8 == 0) { const f32x2 v = pw[32 * 64 + n]; float* A32 = (float*)(a.ws + WS_A32); A32[(g * 64 + n) * 2] = v.x; A32[(g * 64 + n) * 2 + 1] = v.y; }
        for (int p = 0; p < 16; ++p) { const double br = (double)b_re[(g * 64 + n) * 16 + p], bi = (double)b_im[(g * 64 + n) * 16 + p];
            Bb[n * 16 + p] = (f32x2){(float)(fre * br - fim * bi), (float)(fre * bi + fim * br)}; }
    }
    for (int i = tid; i < 1024; i += 512) { const int p = i >> 6, n = i & 63; Cc[p * 64 + n] = (f32x2){c_re[(g * 16 + p) * 64 + n], c_im[(g * 16 + p) * 64 + n]}; }
    __syncthreads();
    for (int i = tid; i < 1024; i += 512) { const int dd = i >> 8, p = (i >> 4) & 15, pp = i & 15; const int d = 4 * q8 + dd; float s = 0.f;
        for (int n = 0; n < 64; ++n) { const f32x2 w = pw[d * 64 + n], b = Bb[n * 16 + pp], c = Cc[p * 64 + n];
            const float wr_ = w.x * b.x - w.y * b.y, wi_ = w.x * b.y + w.y * b.x; s += c.x * wr_ - c.y * wi_; }
        Kt[i] = s; }
    __syncthreads();
    for (int i = tid; i < 4 * 32 * 32; i += 512) { const int dd = i >> 10, tau = (i >> 5) & 31, p = (i >> 1) & 15, pp0 = (i & 1) * 8; const int d = 4 * q8 + dd, sx = tau - d;
        if (sx >= 0) { const LAS float* k = Kt + (dd * 16 + p) * 16 + pp0; u32x4 o; o.x = pk2(k[0], k[1]); o.y = pk2(k[2], k[3]); o.z = pk2(k[4], k[5]); o.w = pk2(k[6], k[7]);
            *(u32x4*)(TCg + (size_t)(tau * 16 + p) * 640 + sx * 16 + pp0) = o; } }
    for (int i = tid; i < 64 * 64; i += 512) { const int rl = i >> 6, ch = i & 63; const int tau = 4 * q8 + (rl >> 4), p = rl & 15, sx = ch >> 1, pp0 = (ch & 1) * 8;
        if (sx > tau) *(u32x4*)(TCg + (size_t)(tau * 16 + p) * 640 + sx * 16 + pp0) = (u32x4){0u, 0u, 0u, 0u}; }
    for (int i = tid; i < 64 * 16; i += 512) { const int rl = i >> 4, ch = i & 15; const int tau = 4 * q8 + (rl >> 4), p = rl & 15; float v[8];
#pragma unroll
        for (int e = 0; e < 8; ++e) { const int c = ch * 8 + e, n = c & 63; const f32x2 w = pw[(tau + 1) * 64 + n], cc = Cc[p * 64 + n];
            v[e] = (c < 64) ? (cc.x * w.x - cc.y * w.y) : -(cc.x * w.y + cc.y * w.x); }
        u32x4 o; o.x = pk2(v[0], v[1]); o.y = pk2(v[2], v[3]); o.z = pk2(v[4], v[5]); o.w = pk2(v[6], v[7]);
        *(u32x4*)(TCg + (size_t)(tau * 16 + p) * 640 + 512 + ch * 8) = o; }
    for (int i = tid; i < 16 * 64; i += 512) { const int rl = i >> 6, ch = i & 63; const int c = 16 * q8 + rl, n = c & 63, s = ch >> 1, pp0 = (ch & 1) * 8; float v[8];
        const f32x2 w = pw[(31 - s) * 64 + n];
#pragma unroll
        for (int e = 0; e < 8; ++e) { const f32x2 b = Bb[n * 16 + pp0 + e]; v[e] = (c < 64) ? (w.x * b.x - w.y * b.y) : (w.x * b.y + w.y * b.x); }
        u32x4 o; o.x = pk2(v[0], v[1]); o.y = pk2(v[2], v[3]); o.z = pk2(v[4], v[5]); o.w = pk2(v[6], v[7]);
        *(u32x4*)(Eg + (size_t)c * 512 + s * 16 + pp0) = o; }
    __syncthreads();
}

__global__ void __launch_bounds__(NWAVES * 64, 2) skel_fwd(Args a) {
    extern __shared__ __attribute__((aligned(16))) unsigned char lds_raw[];
    LAS unsigned char* lds = (LAS unsigned char*)lds_raw;
    const int tid = threadIdx.x, lane = tid & 63, wave = __builtin_amdgcn_readfirstlane(tid >> 6);
    const int G = gridDim.x, bx = blockIdx.x;
    unsigned char* ws = a.ws;
    float* SSQ = (float*)(ws + WS_SSQ);
    float* KM = (float*)(ws + WS_KM);
    bf16_t* XB = (bf16_t*)(ws + WS_XB); bf16_t* PROJ = (bf16_t*)(ws + WS_PROJ); bf16_t* US5 = (bf16_t*)(ws + WS_US5);
    bf16_t* MIX = (bf16_t*)(ws + WS_MIX); bf16_t* HB = (bf16_t*)(ws + WS_H); float* XE = (float*)(ws + WS_XE); bf16_t* YG = (bf16_t*)(ws + WS_YG);
    const int lo = a.ph_lo, hi = a.ph_hi;
    volatile LAS unsigned* xst = (volatile LAS unsigned*)(lds + LDS_BYTES - 64);
    if (tid < 2) xst[tid] = 0u;
    __syncthreads();
    XcdBarrier xbar = xcd_barrier_post((unsigned*)(ws + WS_CTL), xst);
#define IN(k) (lo <= (k) && (k) < hi)
#ifndef PROBE_REP
#define PROBE_REP 0u
#endif
#define NREP(k) (((PROBE_REP >> (k)) & 1u) ? 2 : 1)
#define SEAM(k) do { if ((k) + 1 < hi || rep + 1 < NREP(k)) xcd_barrier(xbar); } while (0)
    unsigned* gctr = (unsigned*)(ws + WS_CTL) + 8192 + (bx & 7) * 16;
#define GSEAM(k, s) do { if ((k) + 1 < hi || rep + 1 < NREP(k)) { if (famok && NREP(k) == 1) fam_barrier(gctr + (s) * 1024, 32u); else xcd_barrier(xbar); } } while (0)
#define GSEAMP(k, s, PRE) do { if ((k) + 1 < hi || rep + 1 < NREP(k)) { if (famok && NREP(k) == 1) fam_barrier(gctr + (s) * 1024, 32u, (unsigned*)nullptr, PRE); else { PRE(); xcd_barrier(xbar); } } } while (0)
    static_assert((PROBE_REP & ((1u << 3) | (1u << 4) | (1u << 5) | (1u << 6) | (1u << 10) | (1u << 11) | (1u << 12) | (1u << 13))) == 0u, "phases around prefetching seams run once");
    auto pre4 = [&]() { pg8::Gemm g{XB, (const bf16_t*)(ws + WS_WGU0), 1024, 1024, 1024, 0, 0}; pg8::StaticOrder S; S.init(MTOK, 2 * FFN, G, bx); pg8::EpiSwiglu E{HB, SSQ + 1 * MTOK}; pg8::gemm_phase<1>(lds, g, S, E); };
    auto pre5 = [&]() { pg8::Gemm g{HB, (const bf16_t*)(ws + WS_WD0), FFN, FFN, FFN, 0, 0}; pg8::StaticOrder S; S.init(MTOK, 1024, G, bx); pg8::EpiResid E{XB, SSQ + 2 * MTOK}; pg8::gemm_phase<1>(lds, g, S, E); };
    auto pre6 = [&]() { pg8::Gemm g{XB, (const bf16_t*)(ws + WS_WIN1), 1024, 1024, 1024, 0, 0}; pg8::StaticOrder S; S.init(MTOK, 2048, G, bx); pg8::EpiProj1 E{US5, PROJ, SSQ + 2 * MTOK, KM, (float*)(ws + WS_KN2)}; pg8::gemm_phase<1>(lds, g, S, E); };
    auto pre11 = [&]() { pg8::Gemm g{MIX, (const bf16_t*)(ws + WS_WOUT1), 1024, 1024, 1024, 0, 0}; pg8::StaticOrder S; S.init(MTOK, 1024, G, bx); pg8::EpiResid E{XB, SSQ + 3 * MTOK}; pg8::gemm_phase<1>(lds, g, S, E); };
    auto pre12 = [&]() { pg8::Gemm g{XB, (const bf16_t*)(ws + WS_WGU1), 1024, 1024, 1024, 0, 0}; pg8::StaticOrder S; S.init(MTOK, 2 * FFN, G, bx); pg8::EpiSwiglu E{HB, SSQ + 3 * MTOK}; pg8::gemm_phase<1>(lds, g, S, E); };
    auto pre13 = [&]() { pg8::Gemm g{HB, (const bf16_t*)(ws + WS_WD1), FFN, FFN, FFN, 0, 0}; pg8::StaticOrder S; S.init(MTOK, 1024, G, bx); pg8::EpiFinal E{XB, SSQ + 4 * MTOK, (unsigned*)(ws + WS_CTL) + 4096, a.in[28], a.out}; pg8::gemm_phase<1>(lds, g, S, E); };

    bool famok = false;
    unsigned* fmask = (unsigned*)(ws + WS_CTL) + 8192 + 5 * 1024;
    if (IN(0) && tid == 0) (void)__hip_atomic_fetch_or(fmask + (bx & 7) * 16, 1u << xb_xcc_id(), __ATOMIC_RELAXED, __HIP_MEMORY_SCOPE_AGENT);
    if (IN(0)) _Pragma("clang loop unroll(disable)") for (int rep = 0; rep < NREP(0); ++rep) {
        LAS float* scr = (LAS float*)(lds + wave * 16384);
        const int gw = bx * NWAVES + wave, NGW = G * NWAVES;
        { const int items0 = 16 * 80;
          for (int it = gw; it < items0; it += NGW) p0_transpose_item(a.in[2], 1024, 2560, (bf16_t*)(ws + WS_WIN0), a.in[1], 0, scr, it, lane); }
        { const float* x = a.in[0];
          for (int r = gw; r < MTOK; r += 2 * NGW) { const int r2 = r + NGW;
              const f32x4* xr = (const f32x4*)(x + (size_t)r * D_MODEL) + lane; const f32x4* xr2 = (const f32x4*)(x + (size_t)r2 * D_MODEL) + lane; f32x4 v[4], w[4]; float s = 0.f, s2 = 0.f;
#pragma unroll
              for (int j = 0; j < 4; ++j) { v[j] = __builtin_nontemporal_load(xr + 64 * j); w[j] = __builtin_nontemporal_load(xr2 + 64 * j); }
#pragma unroll
              for (int j = 0; j < 4; ++j) { s += (v[j][0] * v[j][0] + v[j][1] * v[j][1]) + (v[j][2] * v[j][2] + v[j][3] * v[j][3]); s2 += (w[j][0] * w[j][0] + w[j][1] * w[j][1]) + (w[j][2] * w[j][2] + w[j][3] * w[j][3]); }
              s = wave_sum(s); s2 = wave_sum(s2); if (lane == 0) { SSQ[r] = s; SSQ[r2] = s2; }
              unsigned long long* o8 = (unsigned long long*)(XB + (size_t)r * D_MODEL) + lane; unsigned long long* o82 = (unsigned long long*)(XB + (size_t)r2 * D_MODEL) + lane;
#pragma unroll
              for (int j = 0; j < 4; ++j) { o8[64 * j] = (unsigned long long)pk2(v[j][0], v[j][1]) | ((unsigned long long)pk2(v[j][2], v[j][3]) << 32);
                  o82[64 * j] = (unsigned long long)pk2(w[j][0], w[j][1]) | ((unsigned long long)pk2(w[j][2], w[j][3]) << 32); } } }
        for (int it = bx; it < 256; it += G) p0_s5_ops(a, lds, it >> 3, it & 7);
        SEAM(0);
        if (rep + 1 == NREP(0) && 1 < hi) { bool ok = (G == 256);
#pragma unroll
            for (int j = 0; j < 8; ++j) { const unsigned m = xb_ld(fmask + j * 16); ok = ok && (__builtin_popcount(m) == 1); }
            famok = (bool)__builtin_amdgcn_readfirstlane((int)ok); }
    }
    if (IN(1)) _Pragma("clang loop unroll(disable)") for (int rep = 0; rep < NREP(1); ++rep) {
        pg8::Gemm g{XB, (const bf16_t*)(ws + WS_WIN0), 1024, 1024, 1024, 0, 0}; pg8::StaticOrder S; S.init(MTOK, 2560, G, bx);
        pg8::EpiProj0 E{PROJ, 2560, SSQ};
        pg8::gemm_phase(lds, g, S, E);
        if ((1) + 1 < hi || rep + 1 < NREP(1)) { if (famok && NREP(1) == 1 && NREP(2) == 1) fam_barrier((unsigned*)(ws + WS_CTL) + 8192 + 7 * 1024 + 512 + (bx & 7) * 16, 32u); else xcd_barrier(xbar); }
    }
    if (IN(2)) _Pragma("clang loop unroll(disable)") for (int rep = 0; rep < NREP(2); ++rep) {
        const int fam = bx & 7;
        if (G == 256) { if (bx < 128) { const int j = bx >> 3; rgp::rg_unit(a, PROJ, MIX, fam, j >> 1, j & 1, lds); } }
        else for (int u = bx; u < BATCH * 8 * 2; u += G) rgp::rg_unit(a, PROJ, MIX, u >> 4, (u >> 1) & 7, u & 1, lds);
        unsigned* qw = (unsigned*)(ws + WS_CTL) + 64 + 32 * rep + (G == 256 ? fam : 0);
        LAS unsigned char* vl = lds + wave * 16384;
        { unsigned u = 0; if (lane == 0) u = atomicAdd(qw, 1u); u = (unsigned)__builtin_amdgcn_readfirstlane((int)u);
          const unsigned ulim = (unsigned)(G == 256 ? 8 * 128 : BATCH * 8 * 128);
          while (u < ulim) {
              const int bh = (G == 256 ? fam * 8 : 0) + (int)(u >> 7), qt = 127 - (int)(u & 127);
              u = sbp::sb_unit(PROJ, MIX, bh >> 3, bh & 7, qt, vl, lane, qw); } }
        {
            asm volatile("s_waitcnt vmcnt(0) lgkmcnt(0)" ::: "memory");
            LAS float* scr = (LAS float*)vl;
            unsigned* cw = (unsigned*)(ws + WS_CTL) + 80 + rep;
            const TrJob jobs[10] = {
                {a.in[10], 1024, 1024, (bf16_t*)(ws + WS_WOUT0), nullptr, 0, 16 * 32},
                {a.in[25], 1024, FFN, (bf16_t*)(ws + WS_WGU0), a.in[24], 1, 16 * 88},
                {a.in[26], 1024, FFN, (bf16_t*)(ws + WS_WGU0), a.in[24], 2, 16 * 88},
                {a.in[27], FFN, 1024, (bf16_t*)(ws + WS_WD0), nullptr, 0, 44 * 32},
                {a.in[12], 1024, 2048, (bf16_t*)(ws + WS_WIN1), a.in[11], 0, 16 * 64},
                {a.in[23], 1024, 1024, (bf16_t*)(ws + WS_WOUT1), nullptr, 0, 16 * 32},
                {a.in[25] + (size_t)1024 * FFN, 1024, FFN, (bf16_t*)(ws + WS_WGU1), a.in[24] + 1024, 1, 16 * 88},
                {a.in[26] + (size_t)1024 * FFN, 1024, FFN, (bf16_t*)(ws + WS_WGU1), a.in[24] + 1024, 2, 16 * 88},
                {a.in[27] + (size_t)FFN * 1024, FFN, 1024, (bf16_t*)(ws + WS_WD1), nullptr, 0, 44 * 32},
                {a.in[21], 512, 512, (bf16_t*)(ws + WS_GLU), nullptr, 0, 8 * 16}};
            constexpr int CHUNK = 8, NITEMS = 512 + 1408 * 3 + 1024 + 512 + 1408 * 3 + 128;
            for (;;) {
                unsigned c0 = 0; if (lane == 0) c0 = atomicAdd(cw, 1u); c0 = (unsigned)__builtin_amdgcn_readfirstlane((int)c0);
                if (c0 * CHUNK >= (unsigned)NITEMS) break;
#pragma unroll 1
                for (int q = 0; q < CHUNK; ++q) { int it = (int)c0 * CHUNK + q; if (it >= NITEMS) break;
                    int base = 0;
#pragma unroll
                    for (int j = 0; j < 10; ++j) { const TrJob jb = jobs[j]; if (it >= base && it < base + jb.items) p0_transpose_item(jb.W, jb.K, jb.N, jb.WT, jb.sc, jb.mode, scr, it - base, lane); base += jb.items; } }
            }
        }
        SEAM(2);
    }
    if (IN(3)) _Pragma("clang loop unroll(disable)") for (int rep = 0; rep < NREP(3); ++rep) {
        pg8::Gemm g{MIX, (const bf16_t*)(ws + WS_WOUT0), 1024, 1024, 1024, 0, 0}; pg8::StaticOrder S; S.init(MTOK, 1024, G, bx);
        pg8::EpiResid E{XB, SSQ + 1 * MTOK};
        pg8::gemm_phase(lds, g, S, E); GSEAMP(3, 0, pre4);
    }
    if (IN(4)) _Pragma("clang loop unroll(disable)") for (int rep = 0; rep < NREP(4); ++rep) {
        pg8::Gemm g{XB, (const bf16_t*)(ws + WS_WGU0), 1024, 1024, 1024, 0, 0}; pg8::StaticOrder S; S.init(MTOK, 2 * FFN, G, bx);
        pg8::EpiSwiglu E{HB, SSQ + 1 * MTOK};
        if (lo == 4) pg8::gemm_phase<1>(lds, g, S, E);
        pg8::gemm_phase<2>(lds, g, S, E); GSEAMP(4, 1, pre5);
    }
    if (IN(5)) _Pragma("clang loop unroll(disable)") for (int rep = 0; rep < NREP(5); ++rep) {
        pg8::Gemm g{HB, (const bf16_t*)(ws + WS_WD0), FFN, FFN, FFN, 0, 0}; pg8::StaticOrder S; S.init(MTOK, 1024, G, bx);
        pg8::EpiResid E{XB, SSQ + 2 * MTOK};
        if (lo == 5) pg8::gemm_phase<1>(lds, g, S, E);
        pg8::gemm_phase<2>(lds, g, S, E);
        if ((5) + 1 < hi || rep + 1 < NREP(5)) { if (famok && NREP(5) == 1) fam_barrier(gctr + 6 * 1024, 32u, (unsigned*)(ws + WS_CTL) + 8192 + 7 * 1024, pre6); else { pre6(); xcd_barrier(xbar); } }
    }
    if (IN(6)) _Pragma("clang loop unroll(disable)") for (int rep = 0; rep < NREP(6); ++rep) {
        pg8::Gemm g{XB, (const bf16_t*)(ws + WS_WIN1), 1024, 1024, 1024, 0, 0}; pg8::StaticOrder S; S.init(MTOK, 2048, G, bx);
        pg8::EpiProj1 E{US5, PROJ, SSQ + 2 * MTOK, KM, (float*)(ws + WS_KN2)};
        if (lo == 6) pg8::gemm_phase<1>(lds, g, S, E);
        pg8::gemm_phase<2>(lds, g, S, E); SEAM(6);
    }
    if (IN(7)) _Pragma("clang loop unroll(disable)") for (int rep = 0; rep < NREP(7); ++rep) {
        constexpr int NS5 = 64;
        unsigned* ctl = (unsigned*)(ws + WS_CTL);
        if (bx < NS5 && G > NS5) {
            { pg8::Gemm g{US5, (const bf16_t*)(ws + WS_E), US5_LD, 512, 512, 640, 256 * 512}; pg8::GroupOrder S; S.init(4, 1, 32, NS5, bx);
              pg8::EpiXE E{XE};
              pg8::gemm_phase(lds, g, S, E); }
            if (famok && NREP(7) == 1) sub_barrier_sh(ctl + 104 + (bx & 7), NS5 / 8, ctl + 32, 8u); else sub_barrier(ctl + 32 + 3 * rep, NS5);
            { const float* A32 = (const float*)(ws + WS_A32);
              for (int i = bx * 512 + tid; i < BATCH * 32 * 64; i += NS5 * 512) { const int n = i & 63, g = (i >> 6) & 31, b = i >> 11;
                  const float ar = A32[(g * 64 + n) * 2], ai = A32[(g * 64 + n) * 2 + 1]; float xr = 0.f, xi = 0.f;
                  const float* e0 = XE + ((size_t)b * 128 * 32 + g) * 128 + n;
                  bf16_t* d0 = US5 + ((size_t)b * 128 * 32 + g) * 640 + 512 + n;
                  float cr[16], ci[16], nr[16], ni[16];
#pragma unroll
                  for (int s = 0; s < 16; ++s) { cr[s] = e0[(size_t)s * 4096]; ci[s] = e0[(size_t)s * 4096 + 64]; }
#pragma unroll 1
                  for (int jb = 0; jb < 8; ++jb) {
                      if (jb + 1 < 8) {
#pragma unroll
                          for (int s = 0; s < 16; ++s) { nr[s] = e0[(size_t)((jb + 1) * 16 + s) * 4096]; ni[s] = e0[(size_t)((jb + 1) * 16 + s) * 4096 + 64]; } }
#pragma unroll
                      for (int s = 0; s < 16; ++s) { bf16_t* dst = d0 + (size_t)(jb * 16 + s) * 20480; dst[0] = (bf16_t)f2bf(xr); dst[64] = (bf16_t)f2bf(xi);
                          const float t = ar * xr - ai * xi + cr[s]; xi = ar * xi + ai * xr + ci[s]; xr = t; }
#pragma unroll
                      for (int s = 0; s < 16; ++s) { cr[s] = nr[s]; ci[s] = ni[s]; } } } }
            if (famok && NREP(7) == 1) sub_barrier_sh(ctl + 112 + (bx & 7), NS5 / 8, ctl + 33, 8u); else sub_barrier(ctl + 33 + 3 * rep, NS5);
            { pg8::Gemm g{US5, (const bf16_t*)(ws + WS_TC), US5_LD, 640, 640, 640, 512 * 640}; pg8::GroupOrder S; S.init(4, 2, 32, NS5, bx);
              pg8::EpiS5Y E{US5, a.in[20], YG};
              pg8::gemm_phase(lds, g, S, E); }
        }
        {
            unsigned* qw = ctl + 48 + rep;
            volatile LAS unsigned* uq = (volatile LAS unsigned*)(lds + LDS_BYTES - 32);
            __syncthreads();
            if (tid == 0) uq[0] = atomicAdd(qw, 1u);
            for (;;) {
                __syncthreads();
                const unsigned u = (unsigned)__builtin_amdgcn_readfirstlane((int)uq[0]);
                __syncthreads();
                if (u >= (unsigned)(BATCH * 4 * 16)) break;
                int qb, hh; const int bb = u & 7;
                if (u < 256u) { qb = 15 - (int)(u >> 4); hh = 2 + (int)((u >> 3) & 1u); } else if (u < 384u) { qb = 15 - (int)((u - 256u) >> 3); hh = 1; } else { qb = 15 - (int)((u - 384u) >> 3); hh = 0; }
                mbp::moba_unit(PROJ, KM, (const float*)(ws + WS_KN2), MIX, bb, hh, qb, (char*)lds_raw, lds, qw, uq);
            }
        }
        SEAM(7);
    }
    if (IN(10)) _Pragma("clang loop unroll(disable)") for (int rep = 0; rep < NREP(10); ++rep) {
        pg8::Gemm g{YG, (const bf16_t*)(ws + WS_GLU), 512, 512, 512, 0, 0}; pg8::StaticOrder S; S.init(MTOK, 512, G, bx);
        pg8::EpiGlu E{YG, a.in[22], MIX};
        pg8::gemm_phase(lds, g, S, E); GSEAMP(10, 2, pre11);
    }
    if (IN(11)) _Pragma("clang loop unroll(disable)") for (int rep = 0; rep < NREP(11); ++rep) {
        pg8::Gemm g{MIX, (const bf16_t*)(ws + WS_WOUT1), 1024, 1024, 1024, 0, 0}; pg8::StaticOrder S; S.init(MTOK, 1024, G, bx);
        pg8::EpiResid E{XB, SSQ + 3 * MTOK};
        if (lo == 11) pg8::gemm_phase<1>(lds, g, S, E);
        pg8::gemm_phase<2>(lds, g, S, E); GSEAMP(11, 3, pre12);
    }
    if (IN(12)) _Pragma("clang loop unroll(disable)") for (int rep = 0; rep < NREP(12); ++rep) {
        pg8::Gemm g{XB, (const bf16_t*)(ws + WS_WGU1), 1024, 1024, 1024, 0, 0}; pg8::StaticOrder S; S.init(MTOK, 2 * FFN, G, bx);
        pg8::EpiSwiglu E{HB, SSQ + 3 * MTOK};
        if (lo == 12) pg8::gemm_phase<1>(lds, g, S, E);
        pg8::gemm_phase<2>(lds, g, S, E); GSEAMP(12, 4, pre13);
    }
    if (IN(13)) _Pragma("clang loop unroll(disable)") for (int rep = 0; rep < NREP(13); ++rep) {
        pg8::Gemm g{HB, (const bf16_t*)(ws + WS_WD1), FFN, FFN, FFN, 0, 0}; pg8::StaticOrder S; S.init(MTOK, 1024, G, bx);
        pg8::EpiFinal E{XB, SSQ + 4 * MTOK, (unsigned*)(ws + WS_CTL) + 4096, a.in[28], a.out};
        if (lo == 13) pg8::gemm_phase<1>(lds, g, S, E);
        pg8::gemm_phase<2>(lds, g, S, E);
    }
#undef IN
#undef SEAM
#undef GSEAM
#undef GSEAMP
}

extern "C" void kernel_launch(void* const* d_in, const int* in_sizes, int n_in, void* d_out, int out_size, void* d_ws, size_t ws_size, hipStream_t stream) {
    static int grid = 0;
    if (grid == 0) {
        if (n_in != 29 || ws_size < WS_END) { fprintf(stderr, "kernel_launch: bad shapes / workspace (n_in %d, ws %zu, need %zu)\n", n_in, ws_size, (size_t)WS_END); grid = -1; return; }
        int dev = 0, cus = 0;
        (void)hipGetDevice(&dev); (void)hipDeviceGetAttribute(&cus, hipDeviceAttributeMultiprocessorCount, dev);
        if (hipFuncSetAttribute((const void*)skel_fwd, hipFuncAttributeMaxDynamicSharedMemorySize, LDS_BYTES) != hipSuccess) { fprintf(stderr, "hipFuncSetAttribute failed\n"); grid = -1; return; }
        int per_cu = 0;
        if (hipOccupancyMaxActiveBlocksPerMultiprocessor(&per_cu, (const void*)skel_fwd, NWAVES * 64, LDS_BYTES) != hipSuccess || per_cu < 1) { fprintf(stderr, "occupancy query failed (%d)\n", per_cu); per_cu = 1; }
        grid = (cus > 0 ? cus : 256) * (per_cu < 1 ? per_cu : 1);
    }
    if (grid < 0) return;
    (void)hipMemsetAsync((char*)d_ws + WS_CTL, 0, CTL_ZERO_BYTES, stream);
    Args a{};
    for (int i = 0; i < 29; ++i) a.in[i] = (const float*)d_in[i];
    a.out = (float*)d_out; a.ws = (unsigned char*)d_ws;
    a.ph_lo = 0; a.ph_hi = NPHASE;
    void* kargs[] = {&a};
    const hipError_t le = hipLaunchCooperativeKernel((const void*)skel_fwd, dim3(grid), dim3(NWAVES * 64), kargs, LDS_BYTES, stream);
    if (le != hipSuccess) fprintf(stderr, "kernel_launch: cooperative launch failed: %s (grid %d)\n", hipGetErrorString(le), grid);
}
```

```cpp
#include <hip/hip_runtime.h>
#include <cstdint>
#include <cstdio>

constexpr int D_MODEL = 1024, BATCH = 8, SEQ = 4096, MTOK = BATCH * SEQ;
constexpr int FFN = 2816;
constexpr float EPS = 1e-6f;

typedef unsigned short bf16_t;
#define LAS __attribute__((address_space(3)))
typedef short bf16x8 __attribute__((ext_vector_type(8)));
typedef float f32x4 __attribute__((ext_vector_type(4)));
typedef unsigned u32x4 __attribute__((ext_vector_type(4)));

__device__ __forceinline__ float bf2f(bf16_t v) { return __uint_as_float(((unsigned)v) << 16); }
__device__ __forceinline__ unsigned f2bf(float f) { unsigned u = __float_as_uint(f); return (u + 0x7fffu + ((u >> 16) & 1u)) >> 16; }
__device__ __forceinline__ unsigned pk2(float lo, float hi) { return f2bf(lo) | (f2bf(hi) << 16); }
__device__ __forceinline__ unsigned cvt_pk_bf16(float lo, float hi) { unsigned r; asm volatile("v_cvt_pk_bf16_f32 %0, %1, %2" : "=v"(r) : "v"(lo), "v"(hi)); return r; }
template <typename T> __device__ __forceinline__ float ldv(const T* p);
template <> __device__ __forceinline__ float ldv<float>(const float* p) { return *p; }
template <> __device__ __forceinline__ float ldv<bf16_t>(const bf16_t* p) { return bf2f(*p); }
template <typename T> __device__ __forceinline__ void stv(T* p, float v);
template <> __device__ __forceinline__ void stv<float>(float* p, float v) { *p = v; }
template <> __device__ __forceinline__ void stv<bf16_t>(bf16_t* p, float v) { *p = (bf16_t)f2bf(v); }

__device__ __forceinline__ float wave_sum(float v) {
#pragma unroll
    for (int o = 1; o < 64; o <<= 1) v += __shfl_xor(v, o);
    return v;
}
__device__ __forceinline__ float fast_sigmoid(float x) { return __builtin_amdgcn_rcpf(1.f + __builtin_amdgcn_exp2f(-1.4426950408889634f * x)); }
__device__ __forceinline__ float gelu_tanh_fast(float x) { const float u = 0.7978845608028654f * (x + 0.044715f * x * x * x); return x * fast_sigmoid(2.f * u); }
__device__ __forceinline__ float gelu_tanh(float x) { const float u = 0.7978845608028654f * (x + 0.044715f * x * x * x); return 0.5f * x * (1.f + tanhf(u)); }
__device__ __forceinline__ float sigmoidf_(float x) { return 1.f / (1.f + expf(-x)); }
__device__ __forceinline__ float logsig(float x) { return fminf(x, 0.f) - log1pf(expf(-fabsf(x))); }

constexpr size_t MiB = 1u << 20;
constexpr size_t WS_CTL = 0, CTL_ZERO_BYTES = 2 * MiB;
constexpr size_t WS_SSQ = 64 * 1024;
constexpr size_t WS_KM = 768 * 1024;
constexpr size_t WS_KN2 = 1024 * 1024;
constexpr size_t WS_A32 = 1024 * 1024 + 512 * 1024;
constexpr size_t WS_WIN0 = 2 * MiB, WS_WOUT0 = 7 * MiB, WS_WGU0 = 9 * MiB, WS_WD0 = 20 * MiB, WS_WIN1 = 26 * MiB, WS_WOUT1 = 30 * MiB;
constexpr size_t WS_WGU1 = 32 * MiB, WS_WD1 = 43 * MiB, WS_GLU = 49 * MiB, WS_E = 50 * MiB, WS_TC = 58 * MiB;
constexpr size_t WS_XB = 80 * MiB;
constexpr size_t WS_MIX = 144 * MiB;
constexpr size_t WS_YG = 208 * MiB;
constexpr size_t WS_PROJ = 240 * MiB;
constexpr size_t WS_US5 = 336 * MiB;
constexpr size_t WS_XE = 376 * MiB;
constexpr size_t WS_H = 240 * MiB;
constexpr size_t WS_END = 416 * MiB;
constexpr int US5_LD = 32 * 640;

namespace pg8 {
constexpr int BM = 256, BK = 64, HALF = 128, HTB = HALF * BK * 2, STAGE_BYTES = 8 * HTB, NXCD = 8, WGM = 8;
__host__ __device__ __forceinline__ int lds_byte(int r, int c) { const int st = (r >> 4) * 2 + (c >> 5), rr = r & 15, cc = c & 31, ob = rr * 64 + cc * 2; return st * 1024 + (ob ^ (((ob >> 9) & 1) << 5)); }
__host__ __device__ __forceinline__ void stage_rc(int b, int& R, int& C) { const int st = b / 1024, sb = b % 1024, swz = sb ^ (((sb >> 9) & 1) << 5); R = (st >> 1) * 16 + swz / 64; C = (st & 1) * 32 + (swz % 64) / 2; }
__host__ __device__ __forceinline__ int perm32(int rho) { const int n = rho >> 4, i = rho & 15; return 8 * (i >> 2) + 4 * n + (i & 3); }

struct Unit { int pm, pn, g; };
struct Gemm { const bf16_t* A; const bf16_t* Bt; int lda, ldb, K; long a_g, b_g; };

struct StaticOrder {
    int nM, nN, nwg, G, c;
    __device__ void init(int M, int N, int G_, int c_) { nM = M / BM; nN = N / BM; nwg = nM * nN; G = G_; c = c_; }
    __device__ bool next(int i, Unit& u) const {
        const long L = (long)i * G + c; if (L >= nwg) return false;
        int wgid = (int)L; { const int q = nwg / NXCD, r = nwg % NXCD, xcd = wgid % NXCD, off = wgid / NXCD; wgid = (xcd < r ? xcd * (q + 1) : r * (q + 1) + (xcd - r) * q) + off; }
        const int nig = WGM * nN, gid = wgid / nig, fm = gid * WGM, gsz = (nM - fm) < WGM ? (nM - fm) : WGM;
        u.pm = fm + ((wgid % nig) % gsz); u.pn = (wgid % nig) / gsz; u.g = 0; return true;
    }
};
struct GroupOrder {
    int nM, nN, ng, G, c;
    __device__ void init(int nM_, int nN_, int ng_, int G_, int c_) { nM = nM_; nN = nN_; ng = ng_; G = G_; c = c_; }
    __device__ bool next(int i, Unit& u) const {
        const int L = i * G + c; if (L >= nM * nN * ng) return false;
        u.g = L / (nM * nN); const int r = L % (nM * nN); u.pn = r / nM; u.pm = r % nM; return true;
    }
};

template <int MODE = 0, class Epi, class Sched, bool ALIGN_EPI = true, bool SP2 = true>
__device__ __forceinline__ void gemm_phase(LAS unsigned char* lds, const Gemm g, const Sched& S, const Epi& E) {
    const int tid = threadIdx.x, wid = __builtin_amdgcn_readfirstlane(tid >> 6), lane = tid & 63, wr = wid >> 2, wc = wid & 3, fr = lane & 15, fq = lane >> 4;
    const int K = g.K, nt = K / BK;
    unsigned voffA[2], voffB[2];
#pragma unroll
    for (int i = 0; i < 2; ++i) { int R, C; stage_rc(tid * 16 + i * 8192, R, C); const int Rb = Epi::PERM ? ((R & ~31) + perm32(R & 31)) : R;
        voffA[i] = (unsigned)(R * g.lda + C) * 2u; voffB[i] = (unsigned)(Rb * g.ldb + C) * 2u; }
    const size_t kstep = (size_t)(BK * 2);
    const size_t hstepA = (size_t)HALF * g.lda * 2, hstepB = (size_t)HALF * g.ldb * 2;
    const unsigned ldsw = (unsigned)wid * 1024u;
    const int aoff = lds_byte(wr * 64 + fr, fq * 8), boff = lds_byte(wc * 32 + fr, fq * 8);
#define PG8_SA(b, h) (((b) * 2 + (h)) * HTB)
#define PG8_SB(b, h) ((4 + (b) * 2 + (h)) * HTB)
#define PG8_STAGE(bufoff, gbase, voff) do { _Pragma("unroll") for (int _i = 0; _i < 2; ++_i) \
        __builtin_amdgcn_global_load_lds((const unsigned*)((const char*)(gbase) + (voff)[_i]), (LAS unsigned*)(lds + (bufoff) + ldsw + _i * 8192), 16, 0, 0); } while (0)
#define PG8_LDA(dst, b, h) do { _Pragma("unroll") for (int m = 0; m < 4; ++m) _Pragma("unroll") for (int k = 0; k < 2; ++k) dst[m][k] = *(const LAS bf16x8*)(lds + PG8_SA(b, h) + aoff + m * 2048 + k * 1024); } while (0)
#define PG8_LDB(dst, b, h) do { _Pragma("unroll") for (int n = 0; n < 2; ++n) _Pragma("unroll") for (int k = 0; k < 2; ++k) dst[n][k] = *(const LAS bf16x8*)(lds + PG8_SB(b, h) + boff + n * 2048 + k * 1024); } while (0)
#define PG8_MMA(ai, bj, At, Bt) do { __builtin_amdgcn_s_setprio(1); _Pragma("unroll") for (int m = 0; m < 4; ++m) _Pragma("unroll") for (int n = 0; n < 2; ++n) _Pragma("unroll") for (int k = 0; k < 2; ++k) \
        acc[ai][bj][m][n] = __builtin_amdgcn_mfma_f32_16x16x32_bf16(Bt[n][k], At[m][k], acc[ai][bj][m][n], 0, 0, 0); __builtin_amdgcn_s_setprio(0); } while (0)
#define PG8_WAIT_V(n) asm volatile("s_waitcnt vmcnt(" #n ")" ::: "memory")
#define PG8_WAIT_L(n) asm volatile("s_waitcnt lgkmcnt(" #n ")" ::: "memory")
#define PG8_BAR __builtin_amdgcn_s_barrier()
#define PG8_SCHED __builtin_amdgcn_sched_barrier(0)
#define PG8_ABASE(u) ((const char*)g.A + ((size_t)(u).g * g.a_g + (size_t)(u).pm * BM * g.lda) * 2)
#define PG8_BBASE(u) ((const char*)g.Bt + ((size_t)(u).g * g.b_g + (size_t)(u).pn * BM * g.ldb) * 2)
    Unit cur, nxt; int ui = 0;
    if (!S.next(0, cur)) return;
    if constexpr (MODE == 1) { const char* pB = PG8_BBASE(cur); PG8_STAGE(PG8_SB(0, 0), pB, voffB); PG8_STAGE(PG8_SB(0, 1), pB + hstepB, voffB); return; }
    f32x4 acc[2][2][4][2];
    E.init(acc, cur, wr, wc, fr, fq);
    bf16x8 At[4][2], B0[2][2], B1[2][2];
    const char* cA = PG8_ABASE(cur); const char* cB = PG8_BBASE(cur);
    static_assert(SP2, "only the SP2 loop is carried here");
    if constexpr (MODE != 2) { PG8_STAGE(PG8_SB(0, 0), cB, voffB); PG8_STAGE(PG8_SB(0, 1), cB + hstepB, voffB); }
    PG8_STAGE(PG8_SA(0, 0), cA, voffA); PG8_STAGE(PG8_SA(0, 1), cA + hstepA, voffA);
    if (wr == 1) PG8_BAR;
    PG8_WAIT_V(2); PG8_BAR;
    PG8_STAGE(PG8_SB(1, 0), cB + kstep, voffB); PG8_STAGE(PG8_SA(1, 0), cA + kstep, voffA); PG8_STAGE(PG8_SB(1, 1), cB + hstepB + kstep, voffB);
    PG8_WAIT_V(6); PG8_BAR;
    for (;;) {
        const bool has_next = S.next(ui + 1, nxt);
        const char* nA = has_next ? PG8_ABASE(nxt) : cA; const char* nB = has_next ? PG8_BBASE(nxt) : cB;
        for (int t = 0; t < nt; t += 2) {
            const bool last = (t == nt - 2);
            const char* a1 = cA + (size_t)(t + 1) * kstep;
            const char* a2 = last ? nA : cA + (size_t)(t + 2) * kstep; const char* b2 = last ? nB : cB + (size_t)(t + 2) * kstep;
            const char* a3 = a2 + kstep; const char* b3 = b2 + kstep;
            PG8_LDB(B0, 0, 0); PG8_LDB(B1, 0, 1); PG8_SCHED; PG8_LDA(At, 0, 0); PG8_STAGE(PG8_SA(1, 1), a1 + hstepA, voffA);
            PG8_WAIT_V(8); PG8_WAIT_L(0); PG8_BAR; PG8_MMA(0, 0, At, B0); PG8_MMA(0, 1, At, B1); PG8_BAR; PG8_SCHED;
            PG8_LDA(At, 0, 1); PG8_STAGE(PG8_SB(0, 0), b2, voffB); PG8_STAGE(PG8_SB(0, 1), b2 + hstepB, voffB); PG8_STAGE(PG8_SA(0, 0), a2, voffA);
            PG8_WAIT_V(8); PG8_WAIT_L(0); PG8_BAR; PG8_MMA(1, 0, At, B0); PG8_MMA(1, 1, At, B1); PG8_BAR; PG8_SCHED;
            PG8_LDB(B0, 1, 0); PG8_LDB(B1, 1, 1); PG8_SCHED; PG8_LDA(At, 1, 0); PG8_STAGE(PG8_SA(0, 1), a2 + hstepA, voffA);
            PG8_WAIT_V(8); PG8_WAIT_L(0); PG8_BAR; PG8_MMA(0, 0, At, B0); PG8_MMA(0, 1, At, B1); PG8_BAR; PG8_SCHED;
            PG8_LDA(At, 1, 1); PG8_STAGE(PG8_SB(1, 0), b3, voffB); PG8_STAGE(PG8_SB(1, 1), b3 + hstepB, voffB); PG8_STAGE(PG8_SA(1, 0), a3, voffA);
            PG8_WAIT_V(8); PG8_WAIT_L(0); PG8_BAR; PG8_MMA(1, 0, At, B0); PG8_MMA(1, 1, At, B1); PG8_BAR; PG8_SCHED;
        }
        if constexpr (ALIGN_EPI) { if (wr == 0) PG8_BAR; }
        E(acc, cur, wr, wc, fr, fq);
        if (!has_next) break;
        E.init(acc, nxt, wr, wc, fr, fq);
        cur = nxt; cA = nA; cB = nB; ++ui;
        if constexpr (ALIGN_EPI) { if (wr == 1) PG8_BAR; }
    }
    PG8_WAIT_V(0);
    if constexpr (!ALIGN_EPI) { if (wr == 0) PG8_BAR; }
    PG8_BAR;
#undef PG8_SA
#undef PG8_SB
#undef PG8_STAGE
#undef PG8_LDA
#undef PG8_LDB
#undef PG8_MMA
#undef PG8_WAIT_V
#undef PG8_WAIT_L
#undef PG8_BAR
#undef PG8_SCHED
#undef PG8_ABASE
#undef PG8_BBASE
}

typedef const f32x4 (&AccRef)[2][2][4][2];
__device__ __forceinline__ u32x4 pack8(f32x4 v0, f32x4 v1) { u32x4 w; w.x = cvt_pk_bf16(v0[0], v0[1]); w.y = cvt_pk_bf16(v0[2], v0[3]); w.z = cvt_pk_bf16(v1[0], v1[1]); w.w = cvt_pk_bf16(v1[2], v1[3]); return w; }
__device__ __forceinline__ float rstd_of(const float* ssq, int row) { return rsqrtf(ssq[row] * (1.f / D_MODEL) + EPS); }

struct EpiProj0 {
    static constexpr bool PERM = true;
    bf16_t* O; int ldc; const float* ssq;
    __device__ __forceinline__ void init(f32x4 (&acc)[2][2][4][2], const Unit&, int, int, int, int) const {
#pragma unroll
        for (int a = 0; a < 2; ++a)
#pragma unroll
            for (int b = 0; b < 2; ++b)
#pragma unroll
                for (int m = 0; m < 4; ++m)
#pragma unroll
                    for (int n = 0; n < 2; ++n) acc[a][b][m][n] = (f32x4){0.f, 0.f, 0.f, 0.f}; }
    __device__ __forceinline__ void operator()(AccRef acc, const Unit& u, int wr, int wc, int fr, int fq) const {
        const int row0 = u.pm * BM + wr * 64 + fr, col0 = u.pn * BM + wc * 32 + 8 * fq;
        float sv[2][4];
#pragma unroll
        for (int ai = 0; ai < 2; ++ai)
#pragma unroll
            for (int m = 0; m < 4; ++m) sv[ai][m] = ssq[row0 + ai * HALF + m * 16];
#pragma unroll
        for (int ai = 0; ai < 2; ++ai)
#pragma unroll
            for (int m = 0; m < 4; ++m) { const int row = row0 + ai * HALF + m * 16; const float rs = rsqrtf(sv[ai][m] * (1.f / D_MODEL) + EPS); bf16_t* rowp = O + (size_t)row * ldc + col0;
#pragma unroll
                for (int bj = 0; bj < 2; ++bj) *(u32x4*)(rowp + bj * HALF) = pack8(acc[ai][bj][m][0] * rs, acc[ai][bj][m][1] * rs); }
    }
};
struct EpiProj1 {
    static constexpr bool PERM = true;
    bf16_t* US5; bf16_t* QKV; const float* ssq; float* KM; float* KN2;
    __device__ __forceinline__ void init(f32x4 (&acc)[2][2][4][2], const Unit&, int, int, int, int) const {
#pragma unroll
        for (int a = 0; a < 2; ++a)
#pragma unroll
            for (int b = 0; b < 2; ++b)
#pragma unroll
                for (int m = 0; m < 4; ++m)
#pragma unroll
                    for (int n = 0; n < 2; ++n) acc[a][b][m][n] = (f32x4){0.f, 0.f, 0.f, 0.f}; }
    __device__ __forceinline__ void operator()(AccRef acc, const Unit& u, int wr, int wc, int fr, int fq) const {
        const int row0 = u.pm * BM + wr * 64 + fr, col0 = u.pn * BM + wc * 32 + 8 * fq;
        const bool isK = (u.pn == 4 || u.pn == 5);
        f32x4 cs[2][2];
#pragma unroll
        for (int bj = 0; bj < 2; ++bj) { cs[bj][0] = (f32x4){0.f, 0.f, 0.f, 0.f}; cs[bj][1] = (f32x4){0.f, 0.f, 0.f, 0.f}; }
        float sv[2][4];
#pragma unroll
        for (int ai = 0; ai < 2; ++ai)
#pragma unroll
            for (int m = 0; m < 4; ++m) sv[ai][m] = ssq[row0 + ai * HALF + m * 16];
#pragma unroll
        for (int ai = 0; ai < 2; ++ai)
#pragma unroll
            for (int m = 0; m < 4; ++m) { const int row = row0 + ai * HALF + m * 16; const float rs = rsqrtf(sv[ai][m] * (1.f / D_MODEL) + EPS);
#pragma unroll
                for (int bj = 0; bj < 2; ++bj) { const f32x4 v0 = acc[ai][bj][m][0] * rs, v1 = acc[ai][bj][m][1] * rs; const int col = col0 + bj * HALF;
                    bf16_t* dst;
                    if (u.pn < 2) dst = US5 + ((size_t)((row >> 5) * 32 + (col >> 4)) * 640 + (row & 31) * 16 + (col & 15));
                    else dst = QKV + (size_t)row * 1536 + (col - 512);
                    *(u32x4*)dst = pack8(v0, v1);
                    cs[bj][0] += v0; cs[bj][1] += v1;
                    if (isK) { float sq = (v0[0] * v0[0] + v0[1] * v0[1]) + (v0[2] * v0[2] + v0[3] * v0[3]) + (v1[0] * v1[0] + v1[1] * v1[1]) + (v1[2] * v1[2] + v1[3] * v1[3]);
                        sq += __shfl_xor(sq, 16); sq += __shfl_xor(sq, 32);
                        if (fq == 0) atomicAdd(KN2 + (size_t)row * 4 + ((col - 1024) >> 7), sq); } } }
        if (isK) {
#pragma unroll
            for (int bj = 0; bj < 2; ++bj)
#pragma unroll
                for (int n = 0; n < 2; ++n)
#pragma unroll
                    for (int e = 0; e < 4; ++e) { float s = cs[bj][n][e]; s += __shfl_xor(s, 1); s += __shfl_xor(s, 2); s += __shfl_xor(s, 4); s += __shfl_xor(s, 8);
                        if (fr == 0) { const int col = col0 + bj * HALF + 4 * n + e - 1024; const int h = col >> 7, d = col & 127, b = u.pm >> 4, blk = u.pm & 15;
                            atomicAdd(KM + ((size_t)((b * 4 + h) * 16 + blk) * 128 + d), s * (1.f / 256.f)); } }
        }
    }
};
struct EpiResid {
    static constexpr bool PERM = true;
    bf16_t* XB; float* ssq;
    __device__ __forceinline__ void init(f32x4 (&acc)[2][2][4][2], const Unit& u, int wr, int wc, int fr, int fq) const {
        const int row0 = u.pm * BM + wr * 64 + fr, col0 = u.pn * BM + wc * 32 + 8 * fq;
        u32x4 ow[2][4][2];
#pragma unroll
        for (int ai = 0; ai < 2; ++ai)
#pragma unroll
            for (int m = 0; m < 4; ++m)
#pragma unroll
                for (int bj = 0; bj < 2; ++bj) ow[ai][m][bj] = __builtin_nontemporal_load((const u32x4*)(XB + (size_t)(row0 + ai * HALF + m * 16) * D_MODEL + col0 + bj * HALF));
#pragma unroll
        for (int ai = 0; ai < 2; ++ai)
#pragma unroll
            for (int m = 0; m < 4; ++m)
#pragma unroll
                for (int bj = 0; bj < 2; ++bj) { const u32x4 w = ow[ai][m][bj];
                    acc[ai][bj][m][0] = (f32x4){__uint_as_float(w.x << 16), __uint_as_float(w.x & 0xffff0000u), __uint_as_float(w.y << 16), __uint_as_float(w.y & 0xffff0000u)};
                    acc[ai][bj][m][1] = (f32x4){__uint_as_float(w.z << 16), __uint_as_float(w.z & 0xffff0000u), __uint_as_float(w.w << 16), __uint_as_float(w.w & 0xffff0000u)}; } }
    __device__ __forceinline__ void operator()(AccRef acc, const Unit& u, int wr, int wc, int fr, int fq) const {
        const int row0 = u.pm * BM + wr * 64 + fr, col0 = u.pn * BM + wc * 32 + 8 * fq;
#pragma unroll
        for (int ai = 0; ai < 2; ++ai) {
#pragma unroll
            for (int m = 0; m < 4; ++m) { const int row = row0 + ai * HALF + m * 16; const size_t off = (size_t)row * D_MODEL + col0; float sq = 0.f;
#pragma unroll
                for (int bj = 0; bj < 2; ++bj) { const f32x4 v0 = acc[ai][bj][m][0], v1 = acc[ai][bj][m][1];
                    *(u32x4*)(XB + off + bj * HALF) = pack8(v0, v1);
                    sq += (v0[0] * v0[0] + v0[1] * v0[1]) + (v0[2] * v0[2] + v0[3] * v0[3]) + (v1[0] * v1[0] + v1[1] * v1[1]) + (v1[2] * v1[2] + v1[3] * v1[3]); }
                sq += __shfl_xor(sq, 16); sq += __shfl_xor(sq, 32);
                if (fq == 0) atomicAdd(ssq + row, sq); }
        }
    }
};
struct EpiFinal {
    static constexpr bool PERM = true;
    const bf16_t* XB; float* ssq; unsigned* cnt; const float* gfin; float* out;
    __device__ __forceinline__ void init(f32x4 (&acc)[2][2][4][2], const Unit& u, int wr, int wc, int fr, int fq) const {
        const int row0 = u.pm * BM + wr * 64 + fr, col0 = u.pn * BM + wc * 32 + 8 * fq;
        u32x4 ow[2][4][2];
#pragma unroll
        for (int ai = 0; ai < 2; ++ai)
#pragma unroll
            for (int m = 0; m < 4; ++m)
#pragma unroll
                for (int bj = 0; bj < 2; ++bj) ow[ai][m][bj] = __builtin_nontemporal_load((const u32x4*)(XB + (size_t)(row0 + ai * HALF + m * 16) * D_MODEL + col0 + bj * HALF));
#pragma unroll
        for (int ai = 0; ai < 2; ++ai)
#pragma unroll
            for (int m = 0; m < 4; ++m)
#pragma unroll
                for (int bj = 0; bj < 2; ++bj) { const u32x4 w = ow[ai][m][bj];
                    acc[ai][bj][m][0] = (f32x4){__uint_as_float(w.x << 16), __uint_as_float(w.x & 0xffff0000u), __uint_as_float(w.y << 16), __uint_as_float(w.y & 0xffff0000u)};
                    acc[ai][bj][m][1] = (f32x4){__uint_as_float(w.z << 16), __uint_as_float(w.z & 0xffff0000u), __uint_as_float(w.w << 16), __uint_as_float(w.w & 0xffff0000u)}; } }
    __device__ __forceinline__ void operator()(f32x4 (&acc)[2][2][4][2], const Unit& u, int wr, int wc, int fr, int fq) const {
        const int row0 = u.pm * BM + wr * 64 + fr, col0 = u.pn * BM + wc * 32 + 8 * fq;
#pragma unroll
        for (int ai = 0; ai < 2; ++ai) {
#pragma unroll
            for (int m = 0; m < 4; ++m) { const int row = row0 + ai * HALF + m * 16; float sq = 0.f;
#pragma unroll
                for (int bj = 0; bj < 2; ++bj) { const f32x4 v0 = acc[ai][bj][m][0], v1 = acc[ai][bj][m][1];
                    sq += (v0[0] * v0[0] + v0[1] * v0[1]) + (v0[2] * v0[2] + v0[3] * v0[3]) + (v1[0] * v1[0] + v1[1] * v1[1]) + (v1[2] * v1[2] + v1[3] * v1[3]); }
                sq += __shfl_xor(sq, 16); sq += __shfl_xor(sq, 32);
                if (fq == 0) atomicAdd(ssq + row, sq); }
        }
        asm volatile("s_waitcnt vmcnt(0) lgkmcnt(0)" ::: "memory"); __builtin_amdgcn_s_barrier(); asm volatile("" ::: "memory");
        if (threadIdx.x == 0) {
            unsigned* c = cnt + 64 * u.pm;
            __builtin_amdgcn_fence(__ATOMIC_RELEASE, "agent");
            asm volatile("s_waitcnt vmcnt(0)" ::: "memory");
            (void)__hip_atomic_fetch_add(c, 1u, __ATOMIC_RELAXED, __HIP_MEMORY_SCOPE_AGENT);
            unsigned sp = 0u;
            while (__hip_atomic_load(c, __ATOMIC_RELAXED, __HIP_MEMORY_SCOPE_AGENT) < 4u) { __builtin_amdgcn_s_sleep(1); if (++sp > (1u << 22)) break; }
            __builtin_amdgcn_fence(__ATOMIC_ACQUIRE, "agent");
            asm volatile("s_waitcnt vmcnt(0)" ::: "memory");
        }
        asm volatile("s_waitcnt vmcnt(0) lgkmcnt(0)" ::: "memory"); __builtin_amdgcn_s_barrier(); asm volatile("" ::: "memory");
        f32x4 gv[2][2];
#pragma unroll
        for (int bj = 0; bj < 2; ++bj) { gv[bj][0] = *(const f32x4*)(gfin + col0 + bj * HALF); gv[bj][1] = *(const f32x4*)(gfin + col0 + bj * HALF + 4); }
        float sv[2][4];
#pragma unroll
        for (int ai = 0; ai < 2; ++ai)
#pragma unroll
            for (int m = 0; m < 4; ++m) sv[ai][m] = __hip_atomic_load(ssq + row0 + ai * HALF + m * 16, __ATOMIC_RELAXED, __HIP_MEMORY_SCOPE_AGENT);
#pragma unroll
        for (int ai = 0; ai < 2; ++ai)
#pragma unroll
            for (int m = 0; m < 4; ++m) { const int row = row0 + ai * HALF + m * 16; const float rs = rsqrtf(sv[ai][m] * (1.f / D_MODEL) + EPS); float* op = out + (size_t)row * D_MODEL + col0;
#pragma unroll
                for (int bj = 0; bj < 2; ++bj) { __builtin_nontemporal_store(acc[ai][bj][m][0] * rs * gv[bj][0], (f32x4*)(op + bj * HALF)); __builtin_nontemporal_store(acc[ai][bj][m][1] * rs * gv[bj][1], (f32x4*)(op + bj * HALF + 4)); } }
    }
};
struct EpiSwiglu {
    static constexpr bool PERM = true;
    bf16_t* H; const float* ssq;
    __device__ __forceinline__ void init(f32x4 (&acc)[2][2][4][2], const Unit&, int, int, int, int) const {
#pragma unroll
        for (int a = 0; a < 2; ++a)
#pragma unroll
            for (int b = 0; b < 2; ++b)
#pragma unroll
                for (int m = 0; m < 4; ++m)
#pragma unroll
                    for (int n = 0; n < 2; ++n) acc[a][b][m][n] = (f32x4){0.f, 0.f, 0.f, 0.f}; }
    __device__ __forceinline__ void operator()(AccRef acc, const Unit& u, int wr, int wc, int fr, int fq) const {
        const int row0 = u.pm * BM + wr * 64 + fr, col0 = u.pn * HALF + wc * 32 + 8 * fq;
        float sv[2][4];
#pragma unroll
        for (int ai = 0; ai < 2; ++ai)
#pragma unroll
            for (int m = 0; m < 4; ++m) sv[ai][m] = ssq[row0 + ai * HALF + m * 16];
#pragma unroll
        for (int ai = 0; ai < 2; ++ai)
#pragma unroll
            for (int m = 0; m < 4; ++m) { const int row = row0 + ai * HALF + m * 16; const float rs = rsqrtf(sv[ai][m] * (1.f / D_MODEL) + EPS);
                f32x4 hv[2];
#pragma unroll
                for (int n = 0; n < 2; ++n) { const f32x4 g = acc[ai][0][m][n] * rs, uu = acc[ai][1][m][n] * rs;
#pragma unroll
                    for (int e = 0; e < 4; ++e) hv[n][e] = g[e] * fast_sigmoid(g[e]) * uu[e]; }
                *(u32x4*)(H + (size_t)row * FFN + col0) = pack8(hv[0], hv[1]); }
    }
};
struct EpiXE {
    static constexpr bool PERM = false;
    float* XE;
    __device__ __forceinline__ void init(f32x4 (&acc)[2][2][4][2], const Unit&, int, int, int, int) const {
#pragma unroll
        for (int a = 0; a < 2; ++a)
#pragma unroll
            for (int b = 0; b < 2; ++b)
#pragma unroll
                for (int m = 0; m < 4; ++m)
#pragma unroll
                    for (int n = 0; n < 2; ++n) acc[a][b][m][n] = (f32x4){0.f, 0.f, 0.f, 0.f}; }
    __device__ __forceinline__ void operator()(AccRef acc, const Unit& u, int wr, int wc, int fr, int fq) const {
        const int row0 = u.pm * BM + wr * 64 + fr, col0 = wc * 32 + 4 * fq;
#pragma unroll
        for (int ai = 0; ai < 2; ++ai)
#pragma unroll
            for (int m = 0; m < 4; ++m) { const int J = row0 + ai * HALF + m * 16; float* dst = XE + ((size_t)J * 32 + u.g) * 128 + col0;
#pragma unroll
                for (int n = 0; n < 2; ++n) *(f32x4*)(dst + 16 * n) = acc[ai][0][m][n]; }
    }
};
struct EpiS5Y {
    static constexpr bool PERM = true;
    const bf16_t* US5; const float* dskip; bf16_t* YG;
    __device__ __forceinline__ void init(f32x4 (&acc)[2][2][4][2], const Unit& u, int wr, int wc, int fr, int fq) const {
        const int row0 = u.pm * BM + wr * 64 + fr, col0 = u.pn * BM + wc * 32 + 8 * fq;
        u32x4 uv[2][4][2]; f32x4 dv[2][2];
#pragma unroll
        for (int bj = 0; bj < 2; ++bj) { const int p0 = (col0 + bj * HALF) & 15; dv[bj][0] = *(const f32x4*)(dskip + u.g * 16 + p0); dv[bj][1] = *(const f32x4*)(dskip + u.g * 16 + p0 + 4); }
#pragma unroll
        for (int ai = 0; ai < 2; ++ai)
#pragma unroll
            for (int m = 0; m < 4; ++m)
#pragma unroll
                for (int bj = 0; bj < 2; ++bj) { const int col = col0 + bj * HALF; uv[ai][m][bj] = *(const u32x4*)(US5 + ((size_t)(row0 + ai * HALF + m * 16) * 32 + u.g) * 640 + (col >> 4) * 16 + (col & 15)); }
#pragma unroll
        for (int ai = 0; ai < 2; ++ai)
#pragma unroll
            for (int m = 0; m < 4; ++m)
#pragma unroll
                for (int bj = 0; bj < 2; ++bj) { const u32x4 uw = uv[ai][m][bj]; const f32x4 d0 = dv[bj][0], d1 = dv[bj][1];
                    acc[ai][bj][m][0] = (f32x4){d0[0] * __uint_as_float(uw.x << 16), d0[1] * __uint_as_float(uw.x & 0xffff0000u), d0[2] * __uint_as_float(uw.y << 16), d0[3] * __uint_as_float(uw.y & 0xffff0000u)};
                    acc[ai][bj][m][1] = (f32x4){d1[0] * __uint_as_float(uw.z << 16), d1[1] * __uint_as_float(uw.z & 0xffff0000u), d1[2] * __uint_as_float(uw.w << 16), d1[3] * __uint_as_float(uw.w & 0xffff0000u)}; } }
    __device__ __forceinline__ void operator()(AccRef acc, const Unit& u, int wr, int wc, int fr, int fq) const {
        const int row0 = u.pm * BM + wr * 64 + fr, col0 = u.pn * BM + wc * 32 + 8 * fq;
#pragma unroll
        for (int ai = 0; ai < 2; ++ai)
#pragma unroll
            for (int m = 0; m < 4; ++m) { const int J = row0 + ai * HALF + m * 16;
#pragma unroll
                for (int bj = 0; bj < 2; ++bj) { const int col = col0 + bj * HALF, tau = col >> 4, p0 = col & 15;
                    f32x4 y0 = acc[ai][bj][m][0], y1 = acc[ai][bj][m][1];
#pragma unroll
                    for (int e = 0; e < 4; ++e) { y0[e] = gelu_tanh_fast(y0[e]); y1[e] = gelu_tanh_fast(y1[e]); }
                    *(u32x4*)(YG + ((size_t)J * 32 + tau) * 512 + u.g * 16 + p0) = pack8(y0, y1); } }
    }
};
struct EpiGlu {
    static constexpr bool PERM = true;
    const bf16_t* YG; const float* bias; bf16_t* MIX;
    __device__ __forceinline__ void init(f32x4 (&acc)[2][2][4][2], const Unit&, int, int, int, int) const {
#pragma unroll
        for (int a = 0; a < 2; ++a)
#pragma unroll
            for (int b = 0; b < 2; ++b)
#pragma unroll
                for (int m = 0; m < 4; ++m)
#pragma unroll
                    for (int n = 0; n < 2; ++n) acc[a][b][m][n] = (f32x4){0.f, 0.f, 0.f, 0.f}; }
    __device__ __forceinline__ void operator()(AccRef acc, const Unit& u, int wr, int wc, int fr, int fq) const {
        const int row0 = u.pm * BM + wr * 64 + fr, col0 = u.pn * BM + wc * 32 + 8 * fq;
#pragma unroll
        for (int ai = 0; ai < 2; ++ai) {
        u32x4 yv[4][2];
#pragma unroll
            for (int m = 0; m < 4; ++m)
#pragma unroll
                for (int bj = 0; bj < 2; ++bj) yv[m][bj] = *(const u32x4*)(YG + (size_t)(row0 + ai * HALF + m * 16) * 512 + col0 + bj * HALF);
#pragma unroll
            for (int m = 0; m < 4; ++m) { const int row = row0 + ai * HALF + m * 16;
#pragma unroll
                for (int bj = 0; bj < 2; ++bj) { const int col = col0 + bj * HALF;
                    const u32x4 yw = yv[m][bj];
                    const f32x4 b0 = *(const f32x4*)(bias + col), b1 = *(const f32x4*)(bias + col + 4);
                    const f32x4 a0 = acc[ai][bj][m][0] + b0, a1 = acc[ai][bj][m][1] + b1;
                    f32x4 o0, o1;
                    o0[0] = __uint_as_float(yw.x << 16) * fast_sigmoid(a0[0]); o0[1] = __uint_as_float(yw.x & 0xffff0000u) * fast_sigmoid(a0[1]);
                    o0[2] = __uint_as_float(yw.y << 16) * fast_sigmoid(a0[2]); o0[3] = __uint_as_float(yw.y & 0xffff0000u) * fast_sigmoid(a0[3]);
                    o1[0] = __uint_as_float(yw.z << 16) * fast_sigmoid(a1[0]); o1[1] = __uint_as_float(yw.z & 0xffff0000u) * fast_sigmoid(a1[1]);
                    o1[2] = __uint_as_float(yw.w << 16) * fast_sigmoid(a1[2]); o1[3] = __uint_as_float(yw.w & 0xffff0000u) * fast_sigmoid(a1[3]);
                    *(u32x4*)(MIX + (size_t)row * D_MODEL + col) = pack8(o0, o1); } }
        }
    }
};
}


namespace sbp {
typedef float f32x16 __attribute__((ext_vector_type(16)));
typedef short s16x4 __attribute__((ext_vector_type(4)));
typedef short v4i16_t __attribute__((ext_vector_type(4)));
__device__ __forceinline__ int crow(int r, int hi) { return (r & 3) + 8 * (r >> 2) + 4 * hi; }
__device__ __forceinline__ s16x4 vtr(LAS const unsigned char* p) { return __builtin_bit_cast(s16x4, __builtin_amdgcn_ds_read_tr16_b64_v4i16((LAS v4i16_t*)p)); }

template <bool DIAG>
__device__ __forceinline__ void sb_weights(const f32x16& p0, const f32x16& p1, int tl  , int hi, float& carry, bf16x8 (&pf)[4]) {
    const float C = 0.125f * 1.4426950408889634f;
    float e[32], rr[32];
#pragma unroll
    for (int i = 0; i < 32; ++i) { const float a = (i < 16) ? p0[i & 15] : p1[i & 15];
        float ev = __builtin_amdgcn_exp2f(fminf(a * C, 80.f)); float rv = __builtin_amdgcn_rcpf(1.f + ev);
        if (DIAG) { const int kidx = (i >> 4) * 32 + crow(i & 15, hi); const bool valid = kidx < tl; ev = valid ? ev : 0.f; rv = valid ? rv : 1.f; }
        e[i] = ev; rr[i] = rv; }
    float T[8];
#pragma unroll
    for (int g = 0; g < 8; ++g) { const float s3 = rr[4 * g + 3], s2 = rr[4 * g + 2] * s3, s1 = rr[4 * g + 1] * s2, s0 = rr[4 * g] * s1;
        e[4 * g + 3] *= s3; e[4 * g + 2] *= s2; e[4 * g + 1] *= s1; e[4 * g] *= s0; T[g] = s0; }
    float run = carry;
#pragma unroll
    for (int g = 7; g >= 0; --g) { auto sw = __builtin_amdgcn_permlane32_swap(__float_as_uint(T[g]), __float_as_uint(T[g]), false, false);
        const float T0 = __uint_as_float(sw[0]), T1 = __uint_as_float(sw[1]);
        const float off1 = run, off0 = run * T1; run = off0 * T0; const float off = hi ? off1 : off0;
        e[4 * g] *= off; e[4 * g + 1] *= off; e[4 * g + 2] *= off; e[4 * g + 3] *= off; }
    carry = run;
#pragma unroll
    for (int s = 0; s < 4; ++s) { u32x4 w; w.x = cvt_pk_bf16(e[8 * s], e[8 * s + 1]); w.y = cvt_pk_bf16(e[8 * s + 2], e[8 * s + 3]); w.z = cvt_pk_bf16(e[8 * s + 4], e[8 * s + 5]); w.w = cvt_pk_bf16(e[8 * s + 6], e[8 * s + 7]);
        pf[s] = __builtin_bit_cast(bf16x8, w); }
}

__device__ __forceinline__ unsigned sb_unit(const bf16_t* __restrict__ PROJ, bf16_t* __restrict__ MIX, int b, int h, int qt, LAS unsigned char* vl, int lane, unsigned* qw) {
    const int r32 = lane & 31, hi = lane >> 5;
    const size_t rowbase = (size_t)b * SEQ;
    const int t = qt * 32 + r32;
    const bf16_t* qp = PROJ + (rowbase + t) * 2560 + 1024 + h * 64 + hi * 8;
    const bf16_t* kg = PROJ + rowbase * 2560 + 1536 + h * 64;
    const bf16_t* vg = PROJ + rowbase * 2560 + 2048 + h * 64;
    const unsigned ksrc = (unsigned)((lane >> 3) * 2560 + (((lane & 7) ^ (lane >> 3)) * 8));
    const unsigned vsrc = (unsigned)((lane >> 2) * 2560 + (lane & 3) * 8);
#define SB_DMA_K(k0_) do { _Pragma("unroll") for (int i_ = 0; i_ < 8; ++i_) \
        __builtin_amdgcn_global_load_lds((const unsigned*)(kg + (size_t)((k0_) + 8 * i_) * 2560 + ksrc), (LAS unsigned*)(vl + i_ * 1024), 16, 0, 0); } while (0)
#define SB_DMA_V(k0_) do { _Pragma("unroll") for (int i_ = 0; i_ < 8; ++i_) \
        __builtin_amdgcn_global_load_lds((const unsigned*)(vg + (size_t)((k0_) + 16 * (i_ & 3)) * 2560 + 32 * (i_ >> 2) + vsrc), (LAS unsigned*)(vl + 8192 + i_ * 1024), 16, 0, 0); } while (0)
    asm volatile("s_waitcnt vmcnt(8)" ::: "memory");
    const int kt0 = qt >> 1;
    SB_DMA_K(kt0 * 64); SB_DMA_V(kt0 * 64);
    bf16x8 qf[4];
#pragma unroll
    for (int ks = 0; ks < 4; ++ks) qf[ks] = *(const bf16x8*)(qp + 16 * ks);
    f32x16 o0, o1;
#pragma unroll
    for (int r = 0; r < 16; ++r) { o0[r] = 0.f; o1[r] = 0.f; }
    float carry = 1.f;
    LAS const unsigned char* vrd = vl + 8192 + (4 * hi + ((lane & 15) >> 2)) * 64 + ((lane >> 4) & 1) * 32 + (lane & 3) * 8;
    for (int kt = kt0; kt >= 0; --kt) {
        const int k0 = kt * 64;
        asm volatile("s_waitcnt vmcnt(8)" ::: "memory");
        f32x16 p0, p1;
#pragma unroll
        for (int r = 0; r < 16; ++r) { p0[r] = 0.f; p1[r] = 0.f; }
        __builtin_amdgcn_s_setprio(1);
#pragma unroll
        for (int ks = 0; ks < 4; ++ks) { const int c = 2 * ks + hi;
            const bf16x8 ka = *(LAS const bf16x8*)(vl + r32 * 128 + ((c ^ (r32 & 7)) << 4)), kb = *(LAS const bf16x8*)(vl + (32 + r32) * 128 + ((c ^ (r32 & 7)) << 4));
            p0 = __builtin_amdgcn_mfma_f32_32x32x16_bf16(ka, qf[ks], p0, 0, 0, 0); p1 = __builtin_amdgcn_mfma_f32_32x32x16_bf16(kb, qf[ks], p1, 0, 0, 0); }
        __builtin_amdgcn_s_setprio(0);
        asm volatile("s_waitcnt lgkmcnt(0)" ::: "memory");
        if (kt > 0) SB_DMA_K(k0 - 64);
        bf16x8 pf[4];
        if (kt == kt0) sb_weights<true>(p0, p1, t - k0, hi, carry, pf); else sb_weights<false>(p0, p1, t - k0, hi, carry, pf);
        if (kt > 0) asm volatile("s_waitcnt vmcnt(8)" ::: "memory"); else asm volatile("s_waitcnt vmcnt(0)" ::: "memory");
        __builtin_amdgcn_s_setprio(1);
#pragma unroll
        for (int s = 0; s < 4; ++s) {
            const s16x4 a0 = vtr(vrd + s * 1024), a1 = vtr(vrd + s * 1024 + 512), c0 = vtr(vrd + 4096 + s * 1024), c1 = vtr(vrd + 4096 + s * 1024 + 512);
            const bf16x8 va = (bf16x8){a0[0], a0[1], a0[2], a0[3], a1[0], a1[1], a1[2], a1[3]}, vc = (bf16x8){c0[0], c0[1], c0[2], c0[3], c1[0], c1[1], c1[2], c1[3]};
            o0 = __builtin_amdgcn_mfma_f32_32x32x16_bf16(va, pf[s], o0, 0, 0, 0);
            o1 = __builtin_amdgcn_mfma_f32_32x32x16_bf16(vc, pf[s], o1, 0, 0, 0);
        }
        __builtin_amdgcn_s_setprio(0);
        asm volatile("s_waitcnt lgkmcnt(0)" ::: "memory");
        if (__all(carry < 1e-9f)) break;
        if (kt > 0) SB_DMA_V(k0 - 64);
    }
    unsigned nx = 0u; if (lane == 0) nx = atomicAdd(qw, 1u);
    bf16_t* op = MIX + (rowbase + t) * D_MODEL + 512 + h * 64 + 4 * hi;
#pragma unroll
    for (int g = 0; g < 4; ++g) {
        unsigned long long w0 = (unsigned long long)cvt_pk_bf16(o0[4 * g], o0[4 * g + 1]) | ((unsigned long long)cvt_pk_bf16(o0[4 * g + 2], o0[4 * g + 3]) << 32);
        unsigned long long w1 = (unsigned long long)cvt_pk_bf16(o1[4 * g], o1[4 * g + 1]) | ((unsigned long long)cvt_pk_bf16(o1[4 * g + 2], o1[4 * g + 3]) << 32);
        *(unsigned long long*)(op + 8 * g) = w0; *(unsigned long long*)(op + 32 + 8 * g) = w1; }
#undef SB_DMA_K
#undef SB_DMA_V
    return (unsigned)__builtin_amdgcn_readfirstlane((int)nx);
}
}


#define XB_TMO      128
#define XB_XCNT(j)  (256  + 64 * (j))
#define XB_XSUB(j)  (1280 + 64 * (j))
#define XB_XGEN(j)  (2304 + 64 * (j))
#define XB_TOP      3328
#define XB_TOPGEN   3392
#define XCD_BAR_WORDS 3456
#define XB_SPIN_CAP (1u << 18)
__device__ __forceinline__ unsigned xb_ld(unsigned* p)              { return __hip_atomic_load(p, __ATOMIC_RELAXED, __HIP_MEMORY_SCOPE_AGENT); }
__device__ __forceinline__ unsigned xb_add(unsigned* p, unsigned v) { return __hip_atomic_fetch_add(p, v, __ATOMIC_RELAXED, __HIP_MEMORY_SCOPE_AGENT); }
__device__ __forceinline__ unsigned xb_xcc_id() { return (unsigned)__builtin_amdgcn_s_getreg((3 << 11) | 20) & 0xFu; }
#define XB_SPIN(cond, bar) do { unsigned _sp = 0; while (cond) { __builtin_amdgcn_s_sleep(1); \
    if ((++_sp & 255u) == 0u) { if (xb_ld(&(bar)[XB_TMO])) break; if (_sp > XB_SPIN_CAP) { atomicAdd(&(bar)[XB_TMO], 1u); break; } } } } while (0)
struct XcdBarrier { unsigned* bar; unsigned x; volatile LAS unsigned* st; };
__device__ __forceinline__ XcdBarrier xcd_barrier_post(unsigned* bar, volatile LAS unsigned* st) {
    XcdBarrier b; b.bar = bar; b.x = xb_xcc_id(); b.st = st;
    if (threadIdx.x == 0) (void)xb_add(&bar[XB_XCNT(b.x)], 1u);
    return b;
}
__device__ __forceinline__ void xcd_barrier_complete(unsigned* bar, unsigned x, unsigned& nloc, unsigned& nx) {
    const unsigned G = gridDim.x * gridDim.y * gridDim.z;
    unsigned sum, cnt, mine, sp = 0u;
    for (;;) {
        sum = 0u; cnt = 0u; mine = 0u;
#pragma unroll
        for (unsigned j = 0; j < 16; ++j) { const unsigned c = xb_ld(&bar[XB_XCNT(j)]); sum += c; cnt += (c > 0u) ? 1u : 0u; mine = (j == x) ? c : mine; }
        if (sum == G) break;
        __builtin_amdgcn_s_sleep(1);
        if ((++sp & 255u) == 0u) { if (xb_ld(&bar[XB_TMO])) break; if (sp > XB_SPIN_CAP) { atomicAdd(&bar[XB_TMO], 1u); break; } }
    }
    nloc = mine > 0u ? mine : 1u; nx = cnt > 0u ? cnt : 1u;
}
__device__ __forceinline__ void xcd_barrier(const XcdBarrier& b) {
    asm volatile("s_waitcnt vmcnt(0)" ::: "memory");
    __syncthreads();
    if (threadIdx.x == 0) {
        unsigned* bar = b.bar;
        __builtin_amdgcn_s_waitcnt(0);
        unsigned nloc = b.st[0], nx = b.st[1];
        if (nloc == 0u) { xcd_barrier_complete(bar, b.x, nloc, nx); b.st[0] = nloc; b.st[1] = nx; }
        const unsigned old = xb_add(&bar[XB_XSUB(b.x)], 1u);
        const unsigned gen = old / nloc;
        if (old + 1u == (gen + 1u) * nloc) {
            __builtin_amdgcn_fence(__ATOMIC_RELEASE, "agent");
            asm volatile("s_waitcnt vmcnt(0)" ::: "memory");
            const unsigned og = xb_add(&bar[XB_TOP], 1u);
            const unsigned tg = og / nx;
            if (og + 1u == (tg + 1u) * nx) xb_add(&bar[XB_TOPGEN], 1u);
            else XB_SPIN(xb_ld(&bar[XB_TOPGEN]) == tg, bar);
            __builtin_amdgcn_fence(__ATOMIC_ACQUIRE, "agent");
            xb_add(&bar[XB_XGEN(b.x)], 1u);
            asm volatile("s_waitcnt vmcnt(0)" ::: "memory");
        } else {
            XB_SPIN(xb_ld(&bar[XB_XGEN(b.x)]) == gen, bar);
            __builtin_amdgcn_fence(__ATOMIC_ACQUIRE, "agent");
            asm volatile("s_waitcnt vmcnt(0)" ::: "memory");
        }
    }
    __syncthreads();
}

__device__ __forceinline__ void sub_barrier(unsigned* ctr, unsigned n) {
    asm volatile("s_waitcnt vmcnt(0)" ::: "memory");
    __syncthreads();
    if (threadIdx.x == 0) {
        __builtin_amdgcn_fence(__ATOMIC_RELEASE, "agent");
        asm volatile("s_waitcnt vmcnt(0)" ::: "memory");
        (void)xb_add(ctr, 1u);
        unsigned sp = 0u;
        while (xb_ld(ctr) < n) { __builtin_amdgcn_s_sleep(2); if (++sp > (1u << 22)) break; }
        __builtin_amdgcn_fence(__ATOMIC_ACQUIRE, "agent");
        asm volatile("s_waitcnt vmcnt(0)" ::: "memory");
    }
    __syncthreads();
}

__device__ __forceinline__ void sub_barrier_sh(unsigned* loc, unsigned nloc, unsigned* glob, unsigned nglob) {
    asm volatile("s_waitcnt vmcnt(0)" ::: "memory");
    __syncthreads();
    if (threadIdx.x == 0) {
        const unsigned old = xb_add(loc, 1u);
        if (old + 1u == nloc) { __builtin_amdgcn_fence(__ATOMIC_RELEASE, "agent"); asm volatile("s_waitcnt vmcnt(0)" ::: "memory"); (void)xb_add(glob, 1u); }
        unsigned sp = 0u;
        while (xb_ld(glob) < nglob) { __builtin_amdgcn_s_sleep(2); if (++sp > (1u << 22)) break; }
        __builtin_amdgcn_fence(__ATOMIC_ACQUIRE, "agent");
        asm volatile("s_waitcnt vmcnt(0)" ::: "memory");
    }
    __syncthreads();
}

struct NoPre { __device__ __forceinline__ void operator()() const {} };
template <class Pre = NoPre>
__device__ __forceinline__ void fam_barrier(unsigned* ctr, unsigned n, unsigned* glob = nullptr, const Pre& pre = Pre()) {
    asm volatile("s_waitcnt vmcnt(0)" ::: "memory");
    __syncthreads();
    pre();
    if (threadIdx.x == 0) {
        const unsigned old = xb_add(ctr, 1u);
        if (glob == nullptr) {
            if (old + 1u == n) (void)xb_add(ctr + 1, 1u);
            else { unsigned sp = 0u; while (xb_ld(ctr + 1) == 0u) { __builtin_amdgcn_s_sleep(1); if (++sp > (1u << 22)) break; } }
        } else {
            if (old + 1u == n) (void)xb_add(glob, 1u);
            asm volatile("buffer_inv sc1" ::: "memory");
            unsigned sp = 0u; while (xb_ld(glob) < 8u) { __builtin_amdgcn_s_sleep(1); if (++sp > (1u << 22)) break; }
            asm volatile("s_waitcnt vmcnt(0)" ::: "memory");
        }
    }
    __syncthreads();
}

constexpr int NWAVES = 8;
constexpr int RING_BYTES = 131072, LDS_BYTES = 147456;
constexpr int NPHASE = 14;
struct Args { const float* in[29]; float* out; unsigned char* ws; int ph_lo, ph_hi; };


namespace mbp {
typedef float f32x16 __attribute__((ext_vector_type(16)));
typedef short s16x4 __attribute__((ext_vector_type(4)));
constexpr int D = 128, NW = 8, QBLK = 32, KVBLK = 64, LD = 1536;
constexpr float SCALE = 0.088388347648318440f;
constexpr float THR = 8.f;
constexpr float NEG = -1e30f;
constexpr size_t SHM_V = KVBLK * D * 2, SHM_K = KVBLK * D * 2, SHM_ATTN = 2 * SHM_V + 2 * SHM_K + NW * 64 * 4 + 64;
#define KSWZ(row, colB) ((row) * 256 + ((colB) ^ (((row) & 7) << 4)))
#define SBAR() __builtin_amdgcn_sched_barrier(0)
__device__ __forceinline__ int crow(int r, int hi) { return (r & 3) + 8 * (r >> 2) + 4 * hi; }
__device__ __forceinline__ unsigned cvtpk(float lo, float hi) { unsigned r; asm volatile("v_cvt_pk_bf16_f32 %0, %1, %2" : "=v"(r) : "v"(lo), "v"(hi)); return r; }

__device__ __forceinline__ void partialSM(f32x16& p0, f32x16& p1, float& m_reg, float& mn, float& alpha) {
    constexpr float C = SCALE * 1.4426950408889634f;
    float pmax = p0[0];
#pragma unroll
    for (int r = 1; r < 16; ++r) pmax = fmaxf(pmax, p0[r]);
#pragma unroll
    for (int r = 0; r < 16; ++r) pmax = fmaxf(pmax, p1[r]);
    { auto rr = __builtin_amdgcn_permlane32_swap(__float_as_uint(pmax), __float_as_uint(pmax), false, false);
      pmax = fmaxf(__uint_as_float(rr[0]), __uint_as_float(rr[1])); }
    if (__builtin_expect(__all(pmax - m_reg <= THR / SCALE), 1)) { mn = m_reg; alpha = 1.f; }
    else { mn = fmaxf(m_reg, pmax); alpha = __builtin_amdgcn_exp2f((m_reg - mn) * C); m_reg = mn; }
    const float mnC = -mn * C;
#pragma unroll
    for (int r = 0; r < 16; ++r) p0[r] = fmaf(p0[r], C, mnC);
#pragma unroll
    for (int r = 0; r < 16; ++r) p1[r] = fmaf(p1[r], C, mnC);
#pragma unroll
    for (int r = 0; r < 16; ++r) p0[r] = __builtin_amdgcn_exp2f(p0[r]);
}
__device__ __forceinline__ void finishSM(f32x16& p0, f32x16& p1, float alpha, float& l_reg, bf16x8& pa0, bf16x8& pa1, bf16x8& pa2, bf16x8& pa3) {
#pragma unroll
    for (int r = 0; r < 16; ++r) p1[r] = __builtin_amdgcn_exp2f(p1[r]);
    float ps = 0;
#pragma unroll
    for (int r = 0; r < 16; ++r) ps += p0[r];
#pragma unroll
    for (int r = 0; r < 16; ++r) ps += p1[r];
    { auto rr = __builtin_amdgcn_permlane32_swap(__float_as_uint(ps), __float_as_uint(ps), false, false);
      ps = __uint_as_float(rr[0]) + __uint_as_float(rr[1]); }
    l_reg = l_reg * alpha + ps;
#define PK4(P, BASE, OUT) do { unsigned a0 = cvtpk(P[BASE + 0], P[BASE + 1]), a1 = cvtpk(P[BASE + 2], P[BASE + 3]);   \
    unsigned b0 = cvtpk(P[BASE + 4], P[BASE + 5]), b1 = cvtpk(P[BASE + 6], P[BASE + 7]);                              \
    auto r0 = __builtin_amdgcn_permlane32_swap(a0, b0, false, false); auto r1 = __builtin_amdgcn_permlane32_swap(a1, b1, false, false); \
    u32x4 w = {r0[0], r1[0], r0[1], r1[1]}; OUT = *reinterpret_cast<bf16x8*>(&w); } while (0)
    PK4(p0, 0, pa0); PK4(p0, 8, pa1); PK4(p1, 0, pa2); PK4(p1, 8, pa3);
#undef PK4
}
__device__ __forceinline__ void qkt(f32x16& p0, f32x16& p1, const bf16_t* Ks, const bf16x8* qr, int r32, int hi, float base, float cs) {
    const char* kb = (const char*)Ks;
#define KRD(d0) *reinterpret_cast<const bf16x8*>(kb + KSWZ(r32, ((d0) * 16 + hi * 8) * 2))
#define KRD2(d0) *reinterpret_cast<const bf16x8*>(kb + KSWZ(32 + r32, ((d0) * 16 + hi * 8) * 2))
    bf16x8 ka[3], kc[3];
    ka[0] = KRD(0); kc[0] = KRD2(0); ka[1] = KRD(1); kc[1] = KRD2(1);
#pragma unroll
    for (int r = 0; r < 16; ++r) { p0[r] = fmaf(cs, (float)((r & 3) + 8 * (r >> 2)), base); p1[r] = fmaf(cs, (float)(32 + (r & 3) + 8 * (r >> 2)), base); }
    SBAR();
#pragma unroll
    for (int d0 = 0; d0 < 8; ++d0) {
        if (d0 + 2 < 8) { ka[(d0 + 2) % 3] = KRD(d0 + 2); kc[(d0 + 2) % 3] = KRD2(d0 + 2); }
        SBAR();
        p0 = __builtin_amdgcn_mfma_f32_32x32x16_bf16(ka[d0 % 3], qr[d0], p0, 0, 0, 0);
        p1 = __builtin_amdgcn_mfma_f32_32x32x16_bf16(kc[d0 % 3], qr[d0], p1, 0, 0, 0);
        SBAR();
    }
#undef KRD
#undef KRD2
}
__device__ __forceinline__ int v_st(int k, int c) { const int kk = (k & ~0xC) | ((k & 4) << 1) | ((k & 8) >> 1); return ((kk >> 3) * 4 + (c >> 5)) * 512 + ((kk & 7) * 32 + (c & 31)) * 2; }
__device__ __forceinline__ int v_rd_base(int lane) { return ((lane & 3) << 3) | (((lane >> 2) & 3) << 6) | (((lane >> 4) & 1) << 5) | (((lane >> 5) & 1) << 8); }
constexpr int v_rd_off(int d0, int ks, int half) { return d0 * 512 + ks * 4096 + half * 2048; }
template <int OFF> __device__ __forceinline__ s16x4 tr_read(int vb) { s16x4 r; asm volatile("ds_read_b64_tr_b16 %0, %1 offset:%2" : "=&v"(r) : "v"(vb), "i"(OFF) : "memory"); return r; }
template <int D0> __device__ __forceinline__ void pv_one(f32x16& od, int vb, bf16x8 pa0, bf16x8 pa1, bf16x8 pa2, bf16x8 pa3) {
    const s16x4 l0 = tr_read<v_rd_off(D0, 0, 0)>(vb), h0 = tr_read<v_rd_off(D0, 0, 1)>(vb), l1 = tr_read<v_rd_off(D0, 1, 0)>(vb), h1 = tr_read<v_rd_off(D0, 1, 1)>(vb);
    const s16x4 l2 = tr_read<v_rd_off(D0, 2, 0)>(vb), h2 = tr_read<v_rd_off(D0, 2, 1)>(vb), l3 = tr_read<v_rd_off(D0, 3, 0)>(vb), h3 = tr_read<v_rd_off(D0, 3, 1)>(vb);
    asm volatile("s_waitcnt lgkmcnt(0)" ::: "memory"); SBAR();
#define PK(L, H) (bf16x8){L[0], L[1], L[2], L[3], H[0], H[1], H[2], H[3]}
    od = __builtin_amdgcn_mfma_f32_32x32x16_bf16(pa0, PK(l0, h0), od, 0, 0, 0);
    od = __builtin_amdgcn_mfma_f32_32x32x16_bf16(pa1, PK(l1, h1), od, 0, 0, 0);
    od = __builtin_amdgcn_mfma_f32_32x32x16_bf16(pa2, PK(l2, h2), od, 0, 0, 0);
    od = __builtin_amdgcn_mfma_f32_32x32x16_bf16(pa3, PK(l3, h3), od, 0, 0, 0);
#undef PK
}
struct VFrag { s16x4 l0, h0, l1, h1, l2, h2, l3, h3; };
typedef short v4i16m_t __attribute__((ext_vector_type(4)));
template <int OFF> __device__ __forceinline__ s16x4 tr_rd(int vb) { return __builtin_bit_cast(s16x4, __builtin_amdgcn_ds_read_tr16_b64_v4i16((LAS v4i16m_t*)(unsigned)(vb + OFF))); }
template <int D0> __device__ __forceinline__ void v_reads(VFrag& f, int vb) {
    f.l0 = tr_rd<v_rd_off(D0, 0, 0)>(vb); f.h0 = tr_rd<v_rd_off(D0, 0, 1)>(vb); f.l1 = tr_rd<v_rd_off(D0, 1, 0)>(vb); f.h1 = tr_rd<v_rd_off(D0, 1, 1)>(vb);
    f.l2 = tr_rd<v_rd_off(D0, 2, 0)>(vb); f.h2 = tr_rd<v_rd_off(D0, 2, 1)>(vb); f.l3 = tr_rd<v_rd_off(D0, 3, 0)>(vb); f.h3 = tr_rd<v_rd_off(D0, 3, 1)>(vb);
}
__device__ __forceinline__ void v_mma(f32x16& od, const VFrag& f, bf16x8 pa0, bf16x8 pa1, bf16x8 pa2, bf16x8 pa3) {
#define PK(L, H) (bf16x8){L[0], L[1], L[2], L[3], H[0], H[1], H[2], H[3]}
    od = __builtin_amdgcn_mfma_f32_32x32x16_bf16(pa0, PK(f.l0, f.h0), od, 0, 0, 0);
    od = __builtin_amdgcn_mfma_f32_32x32x16_bf16(pa1, PK(f.l1, f.h1), od, 0, 0, 0);
    od = __builtin_amdgcn_mfma_f32_32x32x16_bf16(pa2, PK(f.l2, f.h2), od, 0, 0, 0);
    od = __builtin_amdgcn_mfma_f32_32x32x16_bf16(pa3, PK(f.l3, f.h3), od, 0, 0, 0);
#undef PK
}
__device__ __forceinline__ void pv_d0_pre(f32x16* o, int vb, VFrag& fa, bf16x8 pa0, bf16x8 pa1, bf16x8 pa2, bf16x8 pa3) {
    VFrag fb;
    v_reads<1>(fb, vb); SBAR(); v_mma(o[0], fa, pa0, pa1, pa2, pa3); SBAR();
    v_reads<2>(fa, vb); SBAR(); v_mma(o[1], fb, pa0, pa1, pa2, pa3); SBAR();
    v_reads<3>(fb, vb); SBAR(); v_mma(o[2], fa, pa0, pa1, pa2, pa3); SBAR();
    v_mma(o[3], fb, pa0, pa1, pa2, pa3);
}
__device__ __forceinline__ void pv_d0(f32x16* o, int vb, bf16x8 pa0, bf16x8 pa1, bf16x8 pa2, bf16x8 pa3) {
    pv_one<0>(o[0], vb, pa0, pa1, pa2, pa3); pv_one<1>(o[1], vb, pa0, pa1, pa2, pa3); pv_one<2>(o[2], vb, pa0, pa1, pa2, pa3); pv_one<3>(o[3], vb, pa0, pa1, pa2, pa3);
}

constexpr int SLOT_BYTES = 32768, NSLOT = 4, OFF_WSF = NSLOT * SLOT_BYTES, OFF_NEED = OFF_WSF + NW * 64 * 4;
__device__ __forceinline__ void moba_unit(const bf16_t* __restrict__ QKV, const float* __restrict__ KM, const float* __restrict__ KN2, bf16_t* __restrict__ MIX, int b, int h, int qb, char* lds, LAS unsigned char* ldsL, unsigned* qw, volatile LAS unsigned* uq) {
    const int tid = threadIdx.x, wid = __builtin_amdgcn_readfirstlane(tid >> 6), lane = tid & 63, r32 = lane & 31, hi = lane >> 5;
    float* wsf = (float*)(lds + OFF_WSF) + wid * 64; float* li_l = wsf; float* al_l = wsf + 32;
    unsigned* need_l = (unsigned*)(lds + OFF_NEED);
    const size_t rowbase = (size_t)b * SEQ; const int q0 = qb * 256;
    const bf16_t* Qb = QKV + (rowbase + q0) * LD + h * D;
    const bf16_t* Kh = QKV + rowbase * LD + 512 + h * D;
    const bf16_t* Vh = QKV + rowbase * LD + 1024 + h * D;
    float m_reg = NEG, l_reg = 0; f32x16 o[4];
#pragma unroll
    for (int d = 0; d < 4; ++d)
#pragma unroll
        for (int r = 0; r < 16; ++r) o[d][r] = 0.f;
    bf16x8 qr[8];
    const bf16_t* Qw = Qb + (size_t)(wid * QBLK + r32) * LD + hi * 8;
#pragma unroll
    for (int d0 = 0; d0 < 8; ++d0) qr[d0] = *reinterpret_cast<const bf16x8*>(Qw + d0 * 16);
    unsigned sel = 0u;
    if (qb > 0) {
        f32x16 gs;
#pragma unroll
        for (int r = 0; r < 16; ++r) gs[r] = 0.f;
        const float* km = KM + ((size_t)((b * 4 + h) * 16 + (r32 & 15)) * 128) + hi * 8;
        const bool rowok = r32 < qb;
#pragma unroll
        for (int d0 = 0; d0 < 8; ++d0) { f32x4 k0v = *(const f32x4*)(km + d0 * 16), k1v = *(const f32x4*)(km + d0 * 16 + 4);
            if (!rowok) { k0v = (f32x4){0.f, 0.f, 0.f, 0.f}; k1v = k0v; }
            u32x4 whi, wlo; float rem[8];
            whi.x = pk2(k0v[0], k0v[1]); whi.y = pk2(k0v[2], k0v[3]); whi.z = pk2(k1v[0], k1v[1]); whi.w = pk2(k1v[2], k1v[3]);
            rem[0] = k0v[0] - __uint_as_float(whi.x << 16); rem[1] = k0v[1] - __uint_as_float(whi.x & 0xffff0000u);
            rem[2] = k0v[2] - __uint_as_float(whi.y << 16); rem[3] = k0v[3] - __uint_as_float(whi.y & 0xffff0000u);
            rem[4] = k1v[0] - __uint_as_float(whi.z << 16); rem[5] = k1v[1] - __uint_as_float(whi.z & 0xffff0000u);
            rem[6] = k1v[2] - __uint_as_float(whi.w << 16); rem[7] = k1v[3] - __uint_as_float(whi.w & 0xffff0000u);
            wlo.x = pk2(rem[0], rem[1]); wlo.y = pk2(rem[2], rem[3]); wlo.z = pk2(rem[4], rem[5]); wlo.w = pk2(rem[6], rem[7]);
            gs = __builtin_amdgcn_mfma_f32_32x32x16_bf16(__builtin_bit_cast(bf16x8, whi), qr[d0], gs, 0, 0, 0);
            gs = __builtin_amdgcn_mfma_f32_32x32x16_bf16(__builtin_bit_cast(bf16x8, wlo), qr[d0], gs, 0, 0, 0); }
        float G[16];
#pragma unroll
        for (int r = 0; r < 8; ++r) { auto sw = __builtin_amdgcn_permlane32_swap(__float_as_uint(gs[r]), __float_as_uint(gs[r]), false, false);
            G[(r & 3) + 8 * (r >> 2)] = __uint_as_float(sw[0]); G[(r & 3) + 8 * (r >> 2) + 4] = __uint_as_float(sw[1]); }
#pragma unroll
        for (int rep = 0; rep < 3; ++rep) { int bi = -1; float bv = -INFINITY;
#pragma unroll
            for (int j = 0; j < 16; ++j) if (j < qb && !((sel >> j) & 1u) && (bi < 0 || G[j] > bv)) { bi = j; bv = G[j]; }
            if (bi >= 0) sel |= 1u << bi; }
    }
    float qn2 = 0.f;
#pragma unroll
    for (int d0 = 0; d0 < 8; ++d0) { const u32x4 w = __builtin_bit_cast(u32x4, qr[d0]);
        const float a0 = __uint_as_float(w.x << 16), a1 = __uint_as_float(w.x & 0xffff0000u), a2 = __uint_as_float(w.y << 16), a3 = __uint_as_float(w.y & 0xffff0000u);
        const float a4 = __uint_as_float(w.z << 16), a5 = __uint_as_float(w.z & 0xffff0000u), a6 = __uint_as_float(w.w << 16), a7 = __uint_as_float(w.w & 0xffff0000u);
        qn2 += (a0 * a0 + a1 * a1) + (a2 * a2 + a3 * a3) + (a4 * a4 + a5 * a5) + (a6 * a6 + a7 * a7); }
    { auto sw = __builtin_amdgcn_permlane32_swap(__float_as_uint(qn2), __float_as_uint(qn2), false, false); qn2 = __uint_as_float(sw[0]) + __uint_as_float(sw[1]); }
    float kn2 = 0.f;
    for (int sx = tid; sx < q0 + 256; sx += 512) kn2 = fmaxf(kn2, KN2[(rowbase + sx) * 4 + h]);
    __syncthreads();
    if (tid == 0) { need_l[0] = 0u; need_l[2] = 0u; need_l[3] = 0u; }
    __syncthreads();
    if (sel) atomicOr(need_l, sel);
    atomicMax(need_l + 2, __float_as_uint(kn2)); atomicMax(need_l + 3, __float_as_uint(qn2));
    __syncthreads();
    const unsigned need = (unsigned)__builtin_amdgcn_readfirstlane((int)need_l[0]);
    const float slope = (h == 0) ? 0.25f : (h == 1) ? 0.0625f : (h == 2) ? 0.015625f : 0.00390625f;
    const float smax = sqrtf(__uint_as_float((unsigned)__builtin_amdgcn_readfirstlane((int)need_l[2])) * __uint_as_float((unsigned)__builtin_amdgcn_readfirstlane((int)need_l[3]))) * SCALE * 1.02f;
    const float dthr = (2.f * smax + 30.f) / slope;
    unsigned long long blist = (unsigned long long)qb; int nblk = 1;
    for (int j = qb - 1; j >= 0; --j) if (((need >> j) & 1u) && !((float)(q0 - 256 * j - 255) > dthr)) { blist |= (unsigned long long)j << (4 * nblk); ++nblk; }
    nblk = __builtin_amdgcn_readfirstlane(nblk);
    const int NT = 4 * nblk;
    const int tq = q0 + wid * QBLK + r32;
    const float cs = slope / SCALE;
#define TILE_BLK(n) ((int)((blist >> (4 * ((n) >> 2))) & 15ull))
#define TILE_K0(n) (TILE_BLK(n) * 256 + ((n) & 3) * KVBLK)
    unsigned ksrc[2], vsrc[2];
#pragma unroll
    for (int i = 0; i < 2; ++i) { const int ci = (wid * 2 + i) * 64 + lane; const int row = ci >> 4, c = (ci & 15) ^ (row & 7); ksrc[i] = (unsigned)(row * LD + c * 8);
        const int st = ci >> 5, rr = (ci & 31) >> 2, cc = ci & 3; const int kk = (st >> 2) * 8 + rr; const int k = (kk & ~0xC) | ((kk & 4) << 1) | ((kk & 8) >> 1);
        vsrc[i] = (unsigned)(k * LD + (st & 3) * 32 + cc * 8); }
#define DMA_TILE(n, slot) do { const int k0_ = TILE_K0(n); const bf16_t* kg_ = Kh + (size_t)k0_ * LD; const bf16_t* vg_ = Vh + (size_t)k0_ * LD; \
    _Pragma("unroll") for (int i_ = 0; i_ < 2; ++i_) { \
        __builtin_amdgcn_global_load_lds((const unsigned*)(kg_ + ksrc[i_]), (LAS unsigned*)(ldsL + (slot) * SLOT_BYTES + (wid * 2 + i_) * 1024), 16, 0, 0); \
        __builtin_amdgcn_global_load_lds((const unsigned*)(vg_ + vsrc[i_]), (LAS unsigned*)(ldsL + (slot) * SLOT_BYTES + 16384 + (wid * 2 + i_) * 1024), 16, 0, 0); } } while (0)
    const int vb0 = (int)(uintptr_t)lds + 16384 + v_rd_base(lane);
    DMA_TILE(0, 0); DMA_TILE(1, 1);
    int slot = 0; bool pend = false; int pslot = 0; bf16x8 pa0, pa1, pa2, pa3;
    asm volatile("s_waitcnt vmcnt(4)" ::: "memory");
    if (wid >= 4) __builtin_amdgcn_s_barrier();
    for (int t = 0; t < NT; ++t) {
        if (t + 1 < NT) asm volatile("s_waitcnt vmcnt(4)" ::: "memory"); else asm volatile("s_waitcnt vmcnt(0)" ::: "memory");
        __builtin_amdgcn_s_barrier();
        if (t + 2 < NT) { const int s2 = (slot + 2) & 3; DMA_TILE(t + 2, s2); }
        const int blk = TILE_BLK(t), k0 = blk * 256 + (t & 3) * KVBLK;
        const bool own = (t >> 2) == 0;
        const bool allowed = own || ((sel >> blk) & 1u);
        const bool skip = own ? (k0 > q0 + wid * QBLK + QBLK - 1) : !__any(allowed);
        f32x16 p0, p1;
        __builtin_amdgcn_s_setprio(1);
        VFrag fa;
        if (pend) { v_reads<0>(fa, vb0 + pslot * SLOT_BYTES); }
        if (!skip) {
            const float base = fmaf(-cs, (float)(tq - k0 - 4 * hi), allowed ? 0.f : NEG);
            qkt(p0, p1, (const bf16_t*)(lds + slot * SLOT_BYTES), qr, r32, hi, base, cs);
        }
        if (pend) pv_d0_pre(o, vb0 + pslot * SLOT_BYTES, fa, pa0, pa1, pa2, pa3);
        __builtin_amdgcn_s_setprio(0);
        pend = !skip;
        if (t + 2 < NT) asm volatile("s_waitcnt vmcnt(4)" ::: "memory"); else asm volatile("s_waitcnt vmcnt(0)" ::: "memory");
        asm volatile("s_waitcnt lgkmcnt(0)" ::: "memory");
        __builtin_amdgcn_s_barrier();
        if (!skip) {
            float mn, alpha;
            if (__builtin_amdgcn_readfirstlane((int)(own && k0 + 63 > q0 + wid * QBLK))) {
                asm volatile("" ::: "memory");
#pragma unroll
                for (int r = 0; r < 16; ++r) { const int kv = k0 + crow(r, hi); if (kv > tq) p0[r] = NEG; if (kv + 32 > tq) p1[r] = NEG; } }
            partialSM(p0, p1, m_reg, mn, alpha);
            finishSM(p0, p1, alpha, l_reg, pa0, pa1, pa2, pa3);
            if (__any(alpha < 1.f)) { if (hi == 0) al_l[r32] = alpha; asm volatile("s_waitcnt lgkmcnt(0)" ::: "memory");
#pragma unroll
                for (int d = 0; d < 4; ++d)
#pragma unroll
                    for (int r = 0; r < 16; ++r) o[d][r] *= al_l[crow(r, hi)]; }
            pslot = slot;
        }
        slot = (slot + 1) & 3;
    }
    if (wid < 4) __builtin_amdgcn_s_barrier();
    if (pend) pv_d0(o, vb0 + pslot * SLOT_BYTES, pa0, pa1, pa2, pa3);
    if (hi == 0) li_l[r32] = l_reg; asm volatile("s_waitcnt lgkmcnt(0)" ::: "memory");
    float rli[16];
#pragma unroll
    for (int r = 0; r < 16; ++r) rli[r] = __builtin_amdgcn_rcpf(li_l[crow(r, hi)]);
    unsigned nxu = 0u; if (tid == 0) nxu = atomicAdd(qw, 1u);
    bf16_t* Ow = MIX + (rowbase + q0 + wid * QBLK) * D_MODEL + 512 + h * D;
#pragma unroll
    for (int r = 0; r < 16; ++r) { const int orow = crow(r, hi);
#pragma unroll
        for (int d0 = 0; d0 < 4; ++d0) Ow[(size_t)orow * D_MODEL + d0 * 32 + r32] = (bf16_t)f2bf(o[d0][r] * rli[r]); }
    if (tid == 0) uq[0] = nxu;
#undef TILE_BLK
#undef TILE_K0
#undef DMA_TILE
}
#undef KSWZ
#undef SBAR
}

namespace rgp {
typedef float f32x16 __attribute__((ext_vector_type(16)));
constexpr int XS_BYTES = 33 * 1024;
constexpr int OFF_XS = 0;
constexpr int OFF_GS = 2 * XS_BYTES;
constexpr int OFF_WL = OFF_GS + 32768;
constexpr int OFF_CW = OFF_WL + 32768;
constexpr int OFF_SM = OFF_CW + 1280;
__device__ __forceinline__ float lo16(unsigned w) { return __uint_as_float(w << 16); }
__device__ __forceinline__ float hi16(unsigned w) { return __uint_as_float(w & 0xffff0000u); }
#define RG_LBAR() do { asm volatile("s_waitcnt lgkmcnt(0)" ::: "memory"); __builtin_amdgcn_s_barrier(); asm volatile("" ::: "memory"); } while (0)

__device__ __forceinline__ void rg_unit(const Args& a, const bf16_t* __restrict__ PROJ, bf16_t* __restrict__ MIX, int b, int hd, int jb, LAS unsigned char* lds) {
    const int tid = threadIdx.x, lane = tid & 63, wave = __builtin_amdgcn_readfirstlane(tid >> 6), r32 = lane & 31, hi = lane >> 5;
    const float* conv_w = a.in[3]; const float* conv_b = a.in[4]; const float* wa = a.in[5]; const float* ba = a.in[6];
    const float* wx = a.in[7]; const float* bx = a.in[8]; const float* lam = a.in[9];
    const size_t rowbase = (size_t)b * SEQ;
    typedef float f32x2 __attribute__((ext_vector_type(2)));
    LAS f32x2* SM = (LAS f32x2*)(lds + OFF_SM);
    __syncthreads();
    { const int gate = tid >> 8, ks = (tid >> 6) & 3, h2 = (tid >> 5) & 1, j = tid & 31;
      const float* W = (gate ? wx : wa) + ((size_t)(hd * 64 + 16 * ks + 8 * h2) * 64 + 32 * jb + j);
      float v[8];
#pragma unroll
      for (int e = 0; e < 8; ++e) v[e] = W[e * 64];
#pragma unroll
      for (int k = 0; k < 4; ++k) { const float* cwp = conv_w + k * 512 + hd * 64 + 16 * ks + 8 * h2; float t[8];
#pragma unroll
          for (int e = 0; e < 8; ++e) t[e] = v[e] * cwp[e];
          u32x4 o; o.x = pk2(t[0], t[1]); o.y = pk2(t[2], t[3]); o.z = pk2(t[4], t[5]); o.w = pk2(t[6], t[7]);
          *(LAS u32x4*)(lds + OFF_WL + (k * 512 + tid) * 16) = o; } }
    const int cj = hd * 64 + 32 * jb + r32;
    float cwk[4];
#pragma unroll
    for (int k = 0; k < 4; ++k) cwk[k] = conv_w[k * 512 + cj];
    const float cbj = conv_b[cj]; float baj = ba[cj], bxj = bx[cj];
    { const float* Wa = wa + (size_t)(hd * 64) * 64 + 32 * jb + r32; const float* Wx = wx + (size_t)(hd * 64) * 64 + 32 * jb + r32; const float* cbh = conv_b + hd * 64;
#pragma unroll 16
      for (int c = 0; c < 64; ++c) { const float cbv = cbh[c]; baj = fmaf(Wa[c * 64], cbv, baj); bxj = fmaf(Wx[c * 64], cbv, bxj); } }
    const float lj = lam[cj];
    const float c8sp = -8.f * 1.4426950408889634f * (fmaxf(-lj, 0.f) + log1pf(expf(-fabsf(lj))));
    const unsigned xsrc = (unsigned)((lane >> 3) * 2560 + (((lane & 7) ^ (lane >> 3)) * 8));
    const unsigned gsrc = (unsigned)((lane >> 2) * 2560 + (lane & 3) * 8);
    const bf16_t* xg0 = PROJ + (rowbase) * 2560 + hd * 64;
    const bf16_t* gg0 = PROJ + (rowbase) * 2560 + 512 + hd * 64 + 32 * jb;
#define RG_DMA(st_, par_) do { \
    for (int i_ = wave; i_ < 33; i_ += 8) __builtin_amdgcn_global_load_lds((const unsigned*)(xg0 + (ptrdiff_t)(256 * (st_) - 3 + 8 * i_) * 2560 + xsrc), (LAS unsigned*)(lds + OFF_XS + (par_) * XS_BYTES + i_ * 1024), 16, 0, 0); \
    _Pragma("unroll") for (int i_ = 0; i_ < 2; ++i_) __builtin_amdgcn_global_load_lds((const unsigned*)(gg0 + (size_t)(256 * (st_) + 16 * (wave * 2 + i_)) * 2560 + gsrc), (LAS unsigned*)(lds + OFF_GS + (par_) * 16384 + (wave * 2 + i_) * 1024), 16, 0, 0); } while (0)
    float STc = 0.f;
    RG_DMA(0, 0);
    for (int st = 0; st < 16; ++st) {
        const int par = st & 1;
        LAS const unsigned char* xs = lds + OFF_XS + par * XS_BYTES;
        asm volatile("s_waitcnt vmcnt(0)" ::: "memory"); RG_LBAR();
        if (st + 1 < 16) RG_DMA(st + 1, par ^ 1);
        const bool first = (st == 0);
        f32x16 ga, gx;
#pragma unroll
        for (int r = 0; r < 16; ++r) { ga[r] = baj; gx[r] = bxj; }
#pragma unroll
        for (int k = 0; k < 4; ++k)
#pragma unroll
            for (int ks = 0; ks < 4; ++ks) { const int row = 32 * wave + r32 + k;
                u32x4 xv = *(LAS const u32x4*)(xs + row * 128 + (((2 * ks + hi) ^ (row & 7)) << 4));
                if (first && row < 3) xv = (u32x4){0u, 0u, 0u, 0u};
                const bf16x8 w0 = *(LAS const bf16x8*)(lds + OFF_WL + (k * 512 + ((0 * 4 + ks) * 2 + hi) * 32 + r32) * 16);
                const bf16x8 w1 = *(LAS const bf16x8*)(lds + OFF_WL + (k * 512 + ((1 * 4 + ks) * 2 + hi) * 32 + r32) * 16);
                ga = __builtin_amdgcn_mfma_f32_32x32x16_bf16(__builtin_bit_cast(bf16x8, xv), w0, ga, 0, 0, 0);
                gx = __builtin_amdgcn_mfma_f32_32x32x16_bf16(__builtin_bit_cast(bf16x8, xv), w1, gx, 0, 0, 0); }
        float hl[16], Pl[16], inH[4], inA[4];
        float cumA = 1.f, cumH = 0.f;
        const int cch = (32 * jb + r32) >> 3, cwi = (r32 & 7) * 2;
#pragma unroll
        for (int g = 0; g < 4; ++g) {
            float xv[7];
#pragma unroll
            for (int m = 0; m < 7; ++m) { const int row = 32 * wave + 8 * g + 4 * hi + m;
                xv[m] = bf2f(*(LAS const bf16_t*)(xs + row * 128 + ((cch ^ (row & 7)) << 4) + cwi)); if (first && row < 3) xv[m] = 0.f; }
            float A_ = 1.f, H_ = 0.f;
#pragma unroll
            for (int i = 0; i < 4; ++i) { const int r = 4 * g + i;
                const float xc = cbj + cwk[0] * xv[i] + cwk[1] * xv[i + 1] + cwk[2] * xv[i + 2] + cwk[3] * xv[i + 3];
                const float rg = fast_sigmoid(ga[r]), ig = fast_sigmoid(gx[r]);
                const float la2 = c8sp * rg; const float av = __builtin_amdgcn_exp2f(la2);
                const float x2 = la2 * 1.3862943611198906f;
                const float om = (x2 > -0.25f) ? -x2 * (1.f + x2 * (0.5f + x2 * (0.16666667f + x2 * (0.041666668f + x2 * 0.0083333338f)))) : 1.f - av * av;
                const float bv = __builtin_amdgcn_sqrtf(om) * ig * xc;
                H_ = av * H_ + bv; A_ = av * A_; hl[r] = H_; Pl[r] = A_; }
            auto swA = __builtin_amdgcn_permlane32_swap(__float_as_uint(A_), __float_as_uint(A_), false, false);
            auto swH = __builtin_amdgcn_permlane32_swap(__float_as_uint(H_), __float_as_uint(H_), false, false);
            const float A0 = __uint_as_float(swA[0]), A1 = __uint_as_float(swA[1]), H0 = __uint_as_float(swH[0]), H1 = __uint_as_float(swH[1]);
            const float in1H = A0 * cumH + H0, in1A = A0 * cumA;
            inH[g] = hi ? in1H : cumH; inA[g] = hi ? in1A : cumA;
            cumH = A1 * in1H + H1; cumA = A1 * in1A; }
        if (hi == 0) SM[(par * 8 + wave) * 32 + r32] = (f32x2){cumA, cumH};
        RG_LBAR();
        float xst = STc, myHin = 0.f;
#pragma unroll
        for (int w2 = 0; w2 < 8; ++w2) { const f32x2 sm = SM[(par * 8 + w2) * 32 + r32]; if (w2 == wave) myHin = xst; xst = sm.x * xst + sm.y; }
        STc = xst;
#pragma unroll
        for (int g = 0; g < 4; ++g) { const float inT = inH[g] + inA[g] * myHin;
#pragma unroll
            for (int i = 0; i < 4; ++i) { const int r = 4 * g + i, tt = 8 * g + 4 * hi + i;
                const float h = hl[r] + Pl[r] * inT;
                LAS bf16_t* gp = (LAS bf16_t*)(lds + OFF_GS + par * 16384 + (32 * wave + tt) * 64 + r32 * 2);
                const float gt = bf2f(*gp); *gp = (bf16_t)f2bf(h * gelu_tanh_fast(gt)); } }
        RG_LBAR();
        for (int i = tid; i < 1024; i += 512) { const int row = i >> 2, ch = i & 3;
            *(u32x4*)(MIX + (rowbase + 256 * st + row) * D_MODEL + hd * 64 + 32 * jb + ch * 8) = *(LAS const u32x4*)(lds + OFF_GS + par * 16384 + row * 64 + ch * 16); }
    }
    asm volatile("s_waitcnt vmcnt(0)" ::: "memory");
    __syncthreads();
#undef RG_DMA
}
#undef RG_LBAR
}

__device__ __forceinline__ void p0_transpose_item(const float* W, int K, int N, bf16_t* WT, const float* sc, int mode, LAS float* scr, int item, int lane) {
    const int nblk = N / 32, kb = item / nblk, nb = item % nblk, k0 = 64 * kb, n0 = 32 * nb;
    f32x4 v[8];
#pragma unroll
    for (int i = 0; i < 8; ++i) { const int kk = 8 * i + (lane >> 3); v[i] = __builtin_nontemporal_load((const f32x4*)(W + (size_t)(k0 + kk) * N + n0 + (lane & 7) * 4)); }
#pragma unroll
    for (int i = 0; i < 8; ++i) { const int kk = 8 * i + (lane >> 3); f32x4 w = v[i]; if (sc) w = w * sc[k0 + kk];
        LAS float* d = scr + kk * 33 + (lane & 7) * 4; d[0] = w[0]; d[1] = w[1]; d[2] = w[2]; d[3] = w[3]; }
    asm volatile("s_waitcnt lgkmcnt(0)" ::: "memory");
    const int c = lane & 7;
    const int rbase = (mode == 0) ? n0 : ((n0 >> 7) * 256 + (mode == 2 ? 128 : 0) + (n0 & 127));
#pragma unroll
    for (int j = 0; j < 4; ++j) { const int n = (lane >> 3) + 8 * j; const LAS float* s = scr + (8 * c) * 33 + n;
        u32x4 o; o.x = pk2(s[0 * 33], s[1 * 33]); o.y = pk2(s[2 * 33], s[3 * 33]); o.z = pk2(s[4 * 33], s[5 * 33]); o.w = pk2(s[6 * 33], s[7 * 33]);
        *(u32x4*)(WT + (size_t)(rbase + n) * K + k0 + 8 * c) = o; }
    asm volatile("s_waitcnt lgkmcnt(0)" ::: "memory");
}
struct TrJob { const float* W; int K, N; bf16_t* WT; const float* sc; int mode; int items; };

__device__ __forceinline__ void p0_s5_ops(const Args& a, LAS unsigned char* lds, int g, int q8) {
    typedef float f32x2 __attribute__((ext_vector_type(2)));
    LAS f32x2* pw = (LAS f32x2*)lds;
    LAS f32x2* Bb = (LAS f32x2*)(lds + 33 * 64 * 8);
    LAS f32x2* Cc = (LAS f32x2*)(lds + 33 * 64 * 8 + 8192);
    LAS float* Kt = (LAS float*)(lds + 33 * 64 * 8 + 16384);
    const int tid = threadIdx.x;
    const float* lam_re = a.in[13]; const float* lam_im = a.in[14]; const float* log_dt = a.in[15];
    const float* b_re = a.in[16]; const float* b_im = a.in[17]; const float* c_re = a.in[18]; const float* c_im = a.in[19];
    bf16_t* Eg = (bf16_t*)(a.ws + WS_E) + (size_t)g * 256 * 512;
    bf16_t* TCg = (bf16_t*)(a.ws + WS_TC) + (size_t)g * 512 * 640;
    __syncthreads();
    if (tid < 64) {
        const int n = tid;
        const double dt = exp((double)log_dt[g]), lr = (double)lam_re[g * 64 + n], li = (double)lam_im[g * 64 + n];
        const double mag = exp(lr * dt); double sn, cs; sincos(li * dt, &sn, &cs);
        const double are = mag * cs, aim = mag * sn;
        const double den = lr * lr + li * li, nr = are - 1.0, ni = aim;
        const double fre = (nr * lr + ni * li) / den, fim = (ni * lr - nr * li) / den;
        double pr = 1.0, pi = 0.0;
        for (int d = 0; d <= 32; ++d) { pw[d * 64 + n] = (f32x2){(float)pr, (float)pi}; const double t = pr * are - pi * aim; pi = pr * aim + pi * are; pr = t; }
        if (q8 == 0) { const f32x2 v = pw[32 * 64 + n]; float* A32 = (float*)(a.ws + WS_A32); A32[(g * 64 + n) * 2] = v.x; A32[(g * 64 + n) * 2 + 1] = v.y; }
        for (int p = 0; p < 16; ++p) { const double br = (double)b_re[(g * 64 + n) * 16 + p], bi = (double)b_im[(g * 64 + n) * 16 + p];
            Bb[n * 16 + p] = (f32x2){(float)(fre * br - fim * bi), (float)(fre * bi + fim * br)}; }
    }
    for (int i = tid; i < 1024; i += 512) { const int p = i >> 6, n = i & 63; Cc[p * 64 + n] = (f32x2){c_re[(g * 16 + p) * 64 + n], c_im[(g * 16 + p) * 64 + n]}; }
    __syncthreads();
    for (int i = tid; i < 1024; i += 512) { const int dd = i >> 8, p = (i >> 4) & 15, pp = i & 15; const int d = 4 * q8 + dd; float s = 0.f;
        for (int n = 0; n < 64; ++n) { const f32x2 w = pw[d * 64 + n], b = Bb[n * 16 + pp], c = Cc[p * 64 + n];
            const float wr_ = w.x * b.x - w.y * b.y, wi_ = w.x * b.y + w.y * b.x; s += c.x * wr_ - c.y * wi_; }
        Kt[i] = s; }
    __syncthreads();
    for (int i = tid; i < 4 * 32 * 32; i += 512) { const int dd = i >> 10, tau = (i >> 5) & 31, p = (i >> 1) & 15, pp0 = (i & 1) * 8; const int d = 4 * q8 + dd, sx = tau - d;
        if (sx >= 0) { const LAS float* k = Kt + (dd * 16 + p) * 16 + pp0; u32x4 o; o.x = pk2(k[0], k[1]); o.y = pk2(k[2], k[3]); o.z = pk2(k[4], k[5]); o.w = pk2(k[6], k[7]);
            *(u32x4*)(TCg + (size_t)(tau * 16 + p) * 640 + sx * 16 + pp0) = o; } }
    for (int i = tid; i < 64 * 64; i += 512) { const int rl = i >> 6, ch = i & 63; const int tau = 4 * q8 + (rl >> 4), p = rl & 15, sx = ch >> 1, pp0 = (ch & 1) * 8;
        if (sx > tau) *(u32x4*)(TCg + (size_t)(tau * 16 + p) * 640 + sx * 16 + pp0) = (u32x4){0u, 0u, 0u, 0u}; }
    for (int i = tid; i < 64 * 16; i += 512) { const int rl = i >> 4, ch = i & 15; const int tau = 4 * q8 + (rl >> 4), p = rl & 15; float v[8];
#pragma unroll
        for (int e = 0; e < 8; ++e) { const int c = ch * 8 + e, n = c & 63; const f32x2 w = pw[(tau + 1) * 64 + n], cc = Cc[p * 64 + n];
            v[e] = (c < 64) ? (cc.x * w.x - cc.y * w.y) : -(cc.x * w.y + cc.y * w.x); }
        u32x4 o; o.x = pk2(v[0], v[1]); o.y = pk2(v[2], v[3]); o.z = pk2(v[4], v[5]); o.w = pk2(v[6], v[7]);
        *(u32x4*)(TCg + (size_t)(tau * 16 + p) * 640 + 512 + ch * 8) = o; }
    for (int i = tid; i < 16 * 64; i += 512) { const int rl = i >> 6, ch = i & 63; const int c = 16 * q8 + rl, n = c & 63, s = ch >> 1, pp0 = (ch & 1) * 8; float v[8];
        const f32x2 w = pw[(31 - s) * 64 + n];
#pragma unroll
        for (int e = 0; e < 8; ++e) { const f32x2 b = Bb[n * 16 + pp0 + e]; v[e] = (c < 64) ? (w.x * b.x - w.y * b.y) : (w.x * b.y + w.y * b.x); }
        u32x4 o; o.x = pk2(v[0], v[1]); o.y = pk2(v[2], v[3]); o.z = pk2(v[4], v[5]); o.w = pk2(v[6], v[7]);
        *(u32x4*)(Eg + (size_t)c * 512 + s * 16 + pp0) = o; }
    __syncthreads();
}

__global__ void __launch_bounds__(NWAVES * 64, 2) skel_fwd(Args a) {
    extern __shared__ __attribute__((aligned(16))) unsigned char lds_raw[];
    LAS unsigned char* lds = (LAS unsigned char*)lds_raw;
    const int tid = threadIdx.x, lane = tid & 63, wave = __builtin_amdgcn_readfirstlane(tid >> 6);
    const int G = gridDim.x, bx = blockIdx.x;
    unsigned char* ws = a.ws;
    float* SSQ = (float*)(ws + WS_SSQ);
    float* KM = (float*)(ws + WS_KM);
    bf16_t* XB = (bf16_t*)(ws + WS_XB); bf16_t* PROJ = (bf16_t*)(ws + WS_PROJ); bf16_t* US5 = (bf16_t*)(ws + WS_US5);
    bf16_t* MIX = (bf16_t*)(ws + WS_MIX); bf16_t* HB = (bf16_t*)(ws + WS_H); float* XE = (float*)(ws + WS_XE); bf16_t* YG = (bf16_t*)(ws + WS_YG);
    const int lo = a.ph_lo, hi = a.ph_hi;
    volatile LAS unsigned* xst = (volatile LAS unsigned*)(lds + LDS_BYTES - 64);
    if (tid < 2) xst[tid] = 0u;
    __syncthreads();
    XcdBarrier xbar = xcd_barrier_post((unsigned*)(ws + WS_CTL), xst);
#define IN(k) (lo <= (k) && (k) < hi)
#ifndef PROBE_REP
#define PROBE_REP 0u
#endif
#define NREP(k) (((PROBE_REP >> (k)) & 1u) ? 2 : 1)
#define SEAM(k) do { if ((k) + 1 < hi || rep + 1 < NREP(k)) xcd_barrier(xbar); } while (0)
    unsigned* gctr = (unsigned*)(ws + WS_CTL) + 8192 + (bx & 7) * 16;
#define GSEAM(k, s) do { if ((k) + 1 < hi || rep + 1 < NREP(k)) { if (famok && NREP(k) == 1) fam_barrier(gctr + (s) * 1024, 32u); else xcd_barrier(xbar); } } while (0)
#define GSEAMP(k, s, PRE) do { if ((k) + 1 < hi || rep + 1 < NREP(k)) { if (famok && NREP(k) == 1) fam_barrier(gctr + (s) * 1024, 32u, (unsigned*)nullptr, PRE); else { PRE(); xcd_barrier(xbar); } } } while (0)
    static_assert((PROBE_REP & ((1u << 3) | (1u << 4) | (1u << 5) | (1u << 6) | (1u << 10) | (1u << 11) | (1u << 12) | (1u << 13))) == 0u, "phases around prefetching seams run once");
    auto pre4 = [&]() { pg8::Gemm g{XB, (const bf16_t*)(ws + WS_WGU0), 1024, 1024, 1024, 0, 0}; pg8::StaticOrder S; S.init(MTOK, 2 * FFN, G, bx); pg8::EpiSwiglu E{HB, SSQ + 1 * MTOK}; pg8::gemm_phase<1>(lds, g, S, E); };
    auto pre5 = [&]() { pg8::Gemm g{HB, (const bf16_t*)(ws + WS_WD0), FFN, FFN, FFN, 0, 0}; pg8::StaticOrder S; S.init(MTOK, 1024, G, bx); pg8::EpiResid E{XB, SSQ + 2 * MTOK}; pg8::gemm_phase<1>(lds, g, S, E); };
    auto pre6 = [&]() { pg8::Gemm g{XB, (const bf16_t*)(ws + WS_WIN1), 1024, 1024, 1024, 0, 0}; pg8::StaticOrder S; S.init(MTOK, 2048, G, bx); pg8::EpiProj1 E{US5, PROJ, SSQ + 2 * MTOK, KM, (float*)(ws + WS_KN2)}; pg8::gemm_phase<1>(lds, g, S, E); };
    auto pre11 = [&]() { pg8::Gemm g{MIX, (const bf16_t*)(ws + WS_WOUT1), 1024, 1024, 1024, 0, 0}; pg8::StaticOrder S; S.init(MTOK, 1024, G, bx); pg8::EpiResid E{XB, SSQ + 3 * MTOK}; pg8::gemm_phase<1>(lds, g, S, E); };
    auto pre12 = [&]() { pg8::Gemm g{XB, (const bf16_t*)(ws + WS_WGU1), 1024, 1024, 1024, 0, 0}; pg8::StaticOrder S; S.init(MTOK, 2 * FFN, G, bx); pg8::EpiSwiglu E{HB, SSQ + 3 * MTOK}; pg8::gemm_phase<1>(lds, g, S, E); };
    auto pre13 = [&]() { pg8::Gemm g{HB, (const bf16_t*)(ws + WS_WD1), FFN, FFN, FFN, 0, 0}; pg8::StaticOrder S; S.init(MTOK, 1024, G, bx); pg8::EpiFinal E{XB, SSQ + 4 * MTOK, (unsigned*)(ws + WS_CTL) + 4096, a.in[28], a.out}; pg8::gemm_phase<1>(lds, g, S, E); };

    bool famok = false;
    unsigned* fmask = (unsigned*)(ws + WS_CTL) + 8192 + 5 * 1024;
    if (IN(0) && tid == 0) (void)__hip_atomic_fetch_or(fmask + (bx & 7) * 16, 1u << xb_xcc_id(), __ATOMIC_RELAXED, __HIP_MEMORY_SCOPE_AGENT);
    if (IN(0)) _Pragma("clang loop unroll(disable)") for (int rep = 0; rep < NREP(0); ++rep) {
        LAS float* scr = (LAS float*)(lds + wave * 16384);
        const int gw = bx * NWAVES + wave, NGW = G * NWAVES;
        { const int items0 = 16 * 80;
          for (int it = gw; it < items0; it += NGW) p0_transpose_item(a.in[2], 1024, 2560, (bf16_t*)(ws + WS_WIN0), a.in[1], 0, scr, it, lane); }
        { const float* x = a.in[0];
          for (int r = gw; r < MTOK; r += 2 * NGW) { const int r2 = r + NGW;
              const f32x4* xr = (const f32x4*)(x + (size_t)r * D_MODEL) + lane; const f32x4* xr2 = (const f32x4*)(x + (size_t)r2 * D_MODEL) + lane; f32x4 v[4], w[4]; float s = 0.f, s2 = 0.f;
#pragma unroll
              for (int j = 0; j < 4; ++j) { v[j] = __builtin_nontemporal_load(xr + 64 * j); w[j] = __builtin_nontemporal_load(xr2 + 64 * j); }
#pragma unroll
              for (int j = 0; j < 4; ++j) { s += (v[j][0] * v[j][0] + v[j][1] * v[j][1]) + (v[j][2] * v[j][2] + v[j][3] * v[j][3]); s2 += (w[j][0] * w[j][0] + w[j][1] * w[j][1]) + (w[j][2] * w[j][2] + w[j][3] * w[j][3]); }
              s = wave_sum(s); s2 = wave_sum(s2); if (lane == 0) { SSQ[r] = s; SSQ[r2] = s2; }
              unsigned long long* o8 = (unsigned long long*)(XB + (size_t)r * D_MODEL) + lane; unsigned long long* o82 = (unsigned long long*)(XB + (size_t)r2 * D_MODEL) + lane;
#pragma unroll
              for (int j = 0; j < 4; ++j) { o8[64 * j] = (unsigned long long)pk2(v[j][0], v[j][1]) | ((unsigned long long)pk2(v[j][2], v[j][3]) << 32);
                  o82[64 * j] = (unsigned long long)pk2(w[j][0], w[j][1]) | ((unsigned long long)pk2(w[j][2], w[j][3]) << 32); } } }
        for (int it = bx; it < 256; it += G) p0_s5_ops(a, lds, it >> 3, it & 7);
        SEAM(0);
        if (rep + 1 == NREP(0) && 1 < hi) { bool ok = (G == 256);
#pragma unroll
            for (int j = 0; j < 8; ++j) { const unsigned m = xb_ld(fmask + j * 16); ok = ok && (__builtin_popcount(m) == 1); }
            famok = (bool)__builtin_amdgcn_readfirstlane((int)ok); }
    }
    if (IN(1)) _Pragma("clang loop unroll(disable)") for (int rep = 0; rep < NREP(1); ++rep) {
        pg8::Gemm g{XB, (const bf16_t*)(ws + WS_WIN0), 1024, 1024, 1024, 0, 0}; pg8::StaticOrder S; S.init(MTOK, 2560, G, bx);
        pg8::EpiProj0 E{PROJ, 2560, SSQ};
        pg8::gemm_phase(lds, g, S, E);
        if ((1) + 1 < hi || rep + 1 < NREP(1)) { if (famok && NREP(1) == 1 && NREP(2) == 1) fam_barrier((unsigned*)(ws + WS_CTL) + 8192 + 7 * 1024 + 512 + (bx & 7) * 16, 32u); else xcd_barrier(xbar); }
    }
    if (IN(2)) _Pragma("clang loop unroll(disable)") for (int rep = 0; rep < NREP(2); ++rep) {
        const int fam = bx & 7;
        if (G == 256) { if (bx < 128) { const int j = bx >> 3; rgp::rg_unit(a, PROJ, MIX, fam, j >> 1, j & 1, lds); } }
        else for (int u = bx; u < BATCH * 8 * 2; u += G) rgp::rg_unit(a, PROJ, MIX, u >> 4, (u >> 1) & 7, u & 1, lds);
        unsigned* qw = (unsigned*)(ws + WS_CTL) + 64 + 32 * rep + (G == 256 ? fam : 0);
        LAS unsigned char* vl = lds + wave * 16384;
        { unsigned u = 0; if (lane == 0) u = atomicAdd(qw, 1u); u = (unsigned)__builtin_amdgcn_readfirstlane((int)u);
          const unsigned ulim = (unsigned)(G == 256 ? 8 * 128 : BATCH * 8 * 128);
          while (u < ulim) {
              const int bh = (G == 256 ? fam * 8 : 0) + (int)(u >> 7), qt = 127 - (int)(u & 127);
              u = sbp::sb_unit(PROJ, MIX, bh >> 3, bh & 7, qt, vl, lane, qw); } }
        {
            asm volatile("s_waitcnt vmcnt(0) lgkmcnt(0)" ::: "memory");
            LAS float* scr = (LAS float*)vl;
            unsigned* cw = (unsigned*)(ws + WS_CTL) + 80 + rep;
            const TrJob jobs[10] = {
                {a.in[10], 1024, 1024, (bf16_t*)(ws + WS_WOUT0), nullptr, 0, 16 * 32},
                {a.in[25], 1024, FFN, (bf16_t*)(ws + WS_WGU0), a.in[24], 1, 16 * 88},
                {a.in[26], 1024, FFN, (bf16_t*)(ws + WS_WGU0), a.in[24], 2, 16 * 88},
                {a.in[27], FFN, 1024, (bf16_t*)(ws + WS_WD0), nullptr, 0, 44 * 32},
                {a.in[12], 1024, 2048, (bf16_t*)(ws + WS_WIN1), a.in[11], 0, 16 * 64},
                {a.in[23], 1024, 1024, (bf16_t*)(ws + WS_WOUT1), nullptr, 0, 16 * 32},
                {a.in[25] + (size_t)1024 * FFN, 1024, FFN, (bf16_t*)(ws + WS_WGU1), a.in[24] + 1024, 1, 16 * 88},
                {a.in[26] + (size_t)1024 * FFN, 1024, FFN, (bf16_t*)(ws + WS_WGU1), a.in[24] + 1024, 2, 16 * 88},
                {a.in[27] + (size_t)FFN * 1024, FFN, 1024, (bf16_t*)(ws + WS_WD1), nullptr, 0, 44 * 32},
                {a.in[21], 512, 512, (bf16_t*)(ws + WS_GLU), nullptr, 0, 8 * 16}};
            constexpr int CHUNK = 8, NITEMS = 512 + 1408 * 3 + 1024 + 512 + 1408 * 3 + 128;
            for (;;) {
                unsigned c0 = 0; if (lane == 0) c0 = atomicAdd(cw, 1u); c0 = (unsigned)__builtin_amdgcn_readfirstlane((int)c0);
                if (c0 * CHUNK >= (unsigned)NITEMS) break;
#pragma unroll 1
                for (int q = 0; q < CHUNK; ++q) { int it = (int)c0 * CHUNK + q; if (it >= NITEMS) break;
                    int base = 0;
#pragma unroll
                    for (int j = 0; j < 10; ++j) { const TrJob jb = jobs[j]; if (it >= base && it < base + jb.items) p0_transpose_item(jb.W, jb.K, jb.N, jb.WT, jb.sc, jb.mode, scr, it - base, lane); base += jb.items; } }
            }
        }
        SEAM(2);
    }
    if (IN(3)) _Pragma("clang loop unroll(disable)") for (int rep = 0; rep < NREP(3); ++rep) {
        pg8::Gemm g{MIX, (const bf16_t*)(ws + WS_WOUT0), 1024, 1024, 1024, 0, 0}; pg8::StaticOrder S; S.init(MTOK, 1024, G, bx);
        pg8::EpiResid E{XB, SSQ + 1 * MTOK};
        pg8::gemm_phase(lds, g, S, E); GSEAMP(3, 0, pre4);
    }
    if (IN(4)) _Pragma("clang loop unroll(disable)") for (int rep = 0; rep < NREP(4); ++rep) {
        pg8::Gemm g{XB, (const bf16_t*)(ws + WS_WGU0), 1024, 1024, 1024, 0, 0}; pg8::StaticOrder S; S.init(MTOK, 2 * FFN, G, bx);
        pg8::EpiSwiglu E{HB, SSQ + 1 * MTOK};
        if (lo == 4) pg8::gemm_phase<1>(lds, g, S, E);
        pg8::gemm_phase<2>(lds, g, S, E); GSEAMP(4, 1, pre5);
    }
    if (IN(5)) _Pragma("clang loop unroll(disable)") for (int rep = 0; rep < NREP(5); ++rep) {
        pg8::Gemm g{HB, (const bf16_t*)(ws + WS_WD0), FFN, FFN, FFN, 0, 0}; pg8::StaticOrder S; S.init(MTOK, 1024, G, bx);
        pg8::EpiResid E{XB, SSQ + 2 * MTOK};
        if (lo == 5) pg8::gemm_phase<1>(lds, g, S, E);
        pg8::gemm_phase<2>(lds, g, S, E);
        if ((5) + 1 < hi || rep + 1 < NREP(5)) { if (famok && NREP(5) == 1) fam_barrier(gctr + 6 * 1024, 32u, (unsigned*)(ws + WS_CTL) + 8192 + 7 * 1024, pre6); else { pre6(); xcd_barrier(xbar); } }
    }
    if (IN(6)) _Pragma("clang loop unroll(disable)") for (int rep = 0; rep < NREP(6); ++rep) {
        pg8::Gemm g{XB, (const bf16_t*)(ws + WS_WIN1), 1024, 1024, 1024, 0, 0}; pg8::StaticOrder S; S.init(MTOK, 2048, G, bx);
        pg8::EpiProj1 E{US5, PROJ, SSQ + 2 * MTOK, KM, (float*)(ws + WS_KN2)};
        if (lo == 6) pg8::gemm_phase<1>(lds, g, S, E);
        pg8::gemm_phase<2>(lds, g, S, E); SEAM(6);
    }
    if (IN(7)) _Pragma("clang loop unroll(disable)") for (int rep = 0; rep < NREP(7); ++rep) {
        constexpr int NS5 = 64;
        unsigned* ctl = (unsigned*)(ws + WS_CTL);
        if (bx < NS5 && G > NS5) {
            { pg8::Gemm g{US5, (const bf16_t*)(ws + WS_E), US5_LD, 512, 512, 640, 256 * 512}; pg8::GroupOrder S; S.init(4, 1, 32, NS5, bx);
              pg8::EpiXE E{XE};
              pg8::gemm_phase(lds, g, S, E); }
            if (famok && NREP(7) == 1) sub_barrier_sh(ctl + 104 + (bx & 7), NS5 / 8, ctl + 32, 8u); else sub_barrier(ctl + 32 + 3 * rep, NS5);
            { const float* A32 = (const float*)(ws + WS_A32);
              for (int i = bx * 512 + tid; i < BATCH * 32 * 64; i += NS5 * 512) { const int n = i & 63, g = (i >> 6) & 31, b = i >> 11;
                  const float ar = A32[(g * 64 + n) * 2], ai = A32[(g * 64 + n) * 2 + 1]; float xr = 0.f, xi = 0.f;
                  const float* e0 = XE + ((size_t)b * 128 * 32 + g) * 128 + n;
                  bf16_t* d0 = US5 + ((size_t)b * 128 * 32 + g) * 640 + 512 + n;
                  float cr[16], ci[16], nr[16], ni[16];
#pragma unroll
                  for (int s = 0; s < 16; ++s) { cr[s] = __builtin_nontemporal_load(e0 + (size_t)s * 4096); ci[s] = __builtin_nontemporal_load(e0 + (size_t)s * 4096 + 64); }
#pragma unroll 1
                  for (int jb = 0; jb < 8; ++jb) {
                      if (jb + 1 < 8) {
#pragma unroll
                          for (int s = 0; s < 16; ++s) { nr[s] = __builtin_nontemporal_load(e0 + (size_t)((jb + 1) * 16 + s) * 4096); ni[s] = __builtin_nontemporal_load(e0 + (size_t)((jb + 1) * 16 + s) * 4096 + 64); } }
#pragma unroll
                      for (int s = 0; s < 16; ++s) { bf16_t* dst = d0 + (size_t)(jb * 16 + s) * 20480; dst[0] = (bf16_t)f2bf(xr); dst[64] = (bf16_t)f2bf(xi);
                          const float t = ar * xr - ai * xi + cr[s]; xi = ar * xi + ai * xr + ci[s]; xr = t; }
#pragma unroll
                      for (int s = 0; s < 16; ++s) { cr[s] = nr[s]; ci[s] = ni[s]; } } } }
            if (famok && NREP(7) == 1) sub_barrier_sh(ctl + 112 + (bx & 7), NS5 / 8, ctl + 33, 8u); else sub_barrier(ctl + 33 + 3 * rep, NS5);
            { pg8::Gemm g{US5, (const bf16_t*)(ws + WS_TC), US5_LD, 640, 640, 640, 512 * 640}; pg8::GroupOrder S; S.init(4, 2, 32, NS5, bx);
              pg8::EpiS5Y E{US5, a.in[20], YG};
              pg8::gemm_phase(lds, g, S, E); }
        }
        {
            unsigned* qw = ctl + 48 + rep;
            volatile LAS unsigned* uq = (volatile LAS unsigned*)(lds + LDS_BYTES - 32);
            __syncthreads();
            if (tid == 0) uq[0] = atomicAdd(qw, 1u);
            for (;;) {
                __syncthreads();
                const unsigned u = (unsigned)__builtin_amdgcn_readfirstlane((int)uq[0]);
                __syncthreads();
                if (u >= (unsigned)(BATCH * 4 * 16)) break;
                int qb, hh; const int bb = u & 7;
                if (u < 256u) { qb = 15 - (int)(u >> 4); hh = 2 + (int)((u >> 3) & 1u); } else if (u < 384u) { qb = 15 - (int)((u - 256u) >> 3); hh = 1; } else { qb = 15 - (int)((u - 384u) >> 3); hh = 0; }
                mbp::moba_unit(PROJ, KM, (const float*)(ws + WS_KN2), MIX, bb, hh, qb, (char*)lds_raw, lds, qw, uq);
            }
        }
        SEAM(7);
    }
    if (IN(10)) _Pragma("clang loop unroll(disable)") for (int rep = 0; rep < NREP(10); ++rep) {
        pg8::Gemm g{YG, (const bf16_t*)(ws + WS_GLU), 512, 512, 512, 0, 0}; pg8::StaticOrder S; S.init(MTOK, 512, G, bx);
        pg8::EpiGlu E{YG, a.in[22], MIX};
        pg8::gemm_phase(lds, g, S, E); GSEAMP(10, 2, pre11);
    }
    if (IN(11)) _Pragma("clang loop unroll(disable)") for (int rep = 0; rep < NREP(11); ++rep) {
        pg8::Gemm g{MIX, (const bf16_t*)(ws + WS_WOUT1), 1024, 1024, 1024, 0, 0}; pg8::StaticOrder S; S.init(MTOK, 1024, G, bx);
        pg8::EpiResid E{XB, SSQ + 3 * MTOK};
        if (lo == 11) pg8::gemm_phase<1>(lds, g, S, E);
        pg8::gemm_phase<2>(lds, g, S, E); GSEAMP(11, 3, pre12);
    }
    if (IN(12)) _Pragma("clang loop unroll(disable)") for (int rep = 0; rep < NREP(12); ++rep) {
        pg8::Gemm g{XB, (const bf16_t*)(ws + WS_WGU1), 1024, 1024, 1024, 0, 0}; pg8::StaticOrder S; S.init(MTOK, 2 * FFN, G, bx);
        pg8::EpiSwiglu E{HB, SSQ + 3 * MTOK};
        if (lo == 12) pg8::gemm_phase<1>(lds, g, S, E);
        pg8::gemm_phase<2>(lds, g, S, E); GSEAMP(12, 4, pre13);
    }
    if (IN(13)) _Pragma("clang loop unroll(disable)") for (int rep = 0; rep < NREP(13); ++rep) {
        pg8::Gemm g{HB, (const bf16_t*)(ws + WS_WD1), FFN, FFN, FFN, 0, 0}; pg8::StaticOrder S; S.init(MTOK, 1024, G, bx);
        pg8::EpiFinal E{XB, SSQ + 4 * MTOK, (unsigned*)(ws + WS_CTL) + 4096, a.in[28], a.out};
        if (lo == 13) pg8::gemm_phase<1>(lds, g, S, E);
        pg8::gemm_phase<2>(lds, g, S, E);
    }
#undef IN
#undef SEAM
#undef GSEAM
#undef GSEAMP
}

extern "C" void kernel_launch(void* const* d_in, const int* in_sizes, int n_in, void* d_out, int out_size, void* d_ws, size_t ws_size, hipStream_t stream) {
    static int grid = 0;
    if (grid == 0) {
        if (n_in != 29 || ws_size < WS_END) { fprintf(stderr, "kernel_launch: bad shapes / workspace (n_in %d, ws %zu, need %zu)\n", n_in, ws_size, (size_t)WS_END); grid = -1; return; }
        int dev = 0, cus = 0;
        (void)hipGetDevice(&dev); (void)hipDeviceGetAttribute(&cus, hipDeviceAttributeMultiprocessorCount, dev);
        if (hipFuncSetAttribute((const void*)skel_fwd, hipFuncAttributeMaxDynamicSharedMemorySize, LDS_BYTES) != hipSuccess) { fprintf(stderr, "hipFuncSetAttribute failed\n"); grid = -1; return; }
        int per_cu = 0;
        if (hipOccupancyMaxActiveBlocksPerMultiprocessor(&per_cu, (const void*)skel_fwd, NWAVES * 64, LDS_BYTES) != hipSuccess || per_cu < 1) { fprintf(stderr, "occupancy query failed (%d)\n", per_cu); per_cu = 1; }
        grid = (cus > 0 ? cus : 256) * (per_cu < 1 ? per_cu : 1);
    }
    if (grid < 0) return;
    (void)hipMemsetAsync((char*)d_ws + WS_CTL, 0, CTL_ZERO_BYTES, stream);
    Args a{};
    for (int i = 0; i < 29; ++i) a.in[i] = (const float*)d_in[i];
    a.out = (float*)d_out; a.ws = (unsigned char*)d_ws;
    a.ph_lo = 0; a.ph_hi = NPHASE;
    void* kargs[] = {&a};
    const hipError_t le = hipLaunchCooperativeKernel((const void*)skel_fwd, dim3(grid), dim3(NWAVES * 64), kargs, LDS_BYTES, stream);
    if (le != hipSuccess) fprintf(stderr, "kernel_launch: cooperative launch failed: %s (grid %d)\n", hipGetErrorString(le), grid);
}
```
